# Optimizing an MI355X kernel written in HIP

```python
import math
import jax, jax.numpy as jnp
from jax import lax
import numpy as np

D_MODEL = 1024
BATCH = 4
SEQ = 8192
DEPTH = 1

HEAD_DIM = 64
RWKV_HEADS = 8
RWKV_W = RWKV_HEADS * HEAD_DIM
DECAY_LORA = 64
AAA_LORA = 64
GATE_LORA = 128
RWKV_COLS = 3 * RWKV_W + DECAY_LORA + AAA_LORA + GATE_LORA
RWKV_GN_EPS = 64e-5
N_Q_HEADS = 8
N_KV_HEADS = 2
GQA_GROUP = N_Q_HEADS // N_KV_HEADS
ATT_Q_W = N_Q_HEADS * HEAD_DIM
ATT_KV_W = N_KV_HEADS * HEAD_DIM
ATT_COLS = ATT_Q_W + 2 * ATT_KV_W
WINDOW = 128
ATT_BLOCK = 128
ATT_SCALE = 1.0 / math.sqrt(HEAD_DIM)
NUM_BUCKETS = 32
MAX_DISTANCE = 128
MIX_W = RWKV_W + ATT_Q_W
IN_COLS = RWKV_COLS + ATT_COLS
D_FF = ((8 * D_MODEL // 3 + 255) // 256) * 256
N_MOD = 6
NORM_EPS = 1e-6
NEG_INF = -1e30

kernel_name = "hybrid_rwkv7_swa_sink_block"


def rmsnorm(x, g):
    x = x.astype(jnp.float32)
    return x * lax.rsqrt(jnp.mean(x * x, axis=-1, keepdims=True) + NORM_EPS) * g


def token_shift(t):
    return jnp.pad(t, ((0, 0), (1, 0), (0, 0)))[:, :-1]


def t5_bucket(n):
    max_exact = NUM_BUCKETS // 2
    is_small = n < max_exact
    n_f = jnp.maximum(n, 1).astype(jnp.float32)
    large = max_exact + (jnp.log(n_f / max_exact) / math.log(MAX_DISTANCE / max_exact)
                         * (NUM_BUCKETS - max_exact)).astype(jnp.int32)
    large = jnp.minimum(large, NUM_BUCKETS - 1)
    return jnp.where(is_small, n, large)


def rwkv7_group(p, rwkv_mu, w0, w_lora_up, a0, a_lora_up, g_lora_up, k_k, k_a, r_k, lnx_g, lnx_b):
    B, S, _ = p.shape
    p = p + (token_shift(p) - p) * rwkv_mu
    o = 0
    r = p[..., o:o + RWKV_W]; o += RWKV_W
    k = p[..., o:o + RWKV_W]; o += RWKV_W
    v = p[..., o:o + RWKV_W]; o += RWKV_W
    xw = p[..., o:o + DECAY_LORA]; o += DECAY_LORA
    xa = p[..., o:o + AAA_LORA]; o += AAA_LORA
    xg = p[..., o:o + GATE_LORA]

    w = -jax.nn.softplus(-(w0 + jnp.tanh(xw) @ w_lora_up)) - 0.5
    decay = jnp.exp(-jnp.exp(w))
    a = jax.nn.sigmoid(a0 + xa @ a_lora_up)
    g = jax.nn.sigmoid(xg) @ g_lora_up

    hs = (B, S, RWKV_HEADS, HEAD_DIM)
    kk = (k * k_k).reshape(hs)
    kk = kk / jnp.maximum(jnp.linalg.norm(kk, axis=-1, keepdims=True), 1e-12)
    k = k * (1.0 + (a - 1.0) * k_a)

    r_h, k_h, v_h = r.reshape(hs), k.reshape(hs), v.reshape(hs)
    a_h = a.reshape(hs)
    tm = lambda t: jnp.transpose(t, (1, 0, 2, 3)).astype(jnp.float32)
    xs = (tm(r_h), tm(decay.reshape(hs)), tm(k_h), tm(v_h), tm(-kk), tm(kk * a_h))

    def step(state, inp):
        r_t, w_t, k_t, v_t, a_t, b_t = inp
        sa = jnp.einsum('bhij,bhj->bhi', state, a_t)
        state = (state * w_t[:, :, None, :] + sa[..., None] * b_t[:, :, None, :]
                 + v_t[..., None] * k_t[:, :, None, :])
        return state, jnp.einsum('bhij,bhj->bhi', state, r_t)

    s0 = jnp.zeros((B, RWKV_HEADS, HEAD_DIM, HEAD_DIM), jnp.float32)
    _, y = lax.scan(step, s0, xs)
    y = jnp.transpose(y, (1, 0, 2, 3))

    mu = jnp.mean(y, axis=-1, keepdims=True)
    var = jnp.mean(jnp.square(y - mu), axis=-1, keepdims=True)
    y = ((y - mu) * lax.rsqrt(var + RWKV_GN_EPS)).reshape(B, S, RWKV_W) * lnx_g + lnx_b
    bonus = jnp.sum(r_h * k_h * r_k, axis=-1, keepdims=True) * v_h
    return (y + bonus.reshape(B, S, RWKV_W)) * g


def swa_group(p, q_norm_g, k_norm_g, sinks, rel_bias):
    B, S, _ = p.shape
    nb = S // ATT_BLOCK
    q = p[..., :ATT_Q_W].reshape(B, S, N_KV_HEADS, GQA_GROUP, HEAD_DIM)
    k = p[..., ATT_Q_W:ATT_Q_W + ATT_KV_W].reshape(B, S, N_KV_HEADS, HEAD_DIM)
    v = p[..., ATT_Q_W + ATT_KV_W:].reshape(B, S, N_KV_HEADS, HEAD_DIM)
    q = rmsnorm(q, q_norm_g).reshape(B, nb, ATT_BLOCK, N_KV_HEADS, GQA_GROUP, HEAD_DIM)
    k = rmsnorm(k, k_norm_g)

    def windows(t):
        t = jnp.pad(t, ((0, 0), (ATT_BLOCK, 0), (0, 0), (0, 0)))
        t = t.reshape(B, nb + 1, ATT_BLOCK, N_KV_HEADS, HEAD_DIM)
        return jnp.concatenate([t[:, :-1], t[:, 1:]], axis=2)

    kw, vw = windows(k), windows(v.astype(jnp.float32))
    logits = jnp.einsum('bnqhgd,bnkhd->bnhgqk', q, kw) * ATT_SCALE

    qi = jnp.arange(ATT_BLOCK)[:, None]
    kj = jnp.arange(2 * ATT_BLOCK)[None, :]
    dist = qi + ATT_BLOCK - kj
    bias = rel_bias[t5_bucket(jnp.maximum(dist, 0))]
    bias = jnp.transpose(bias, (2, 0, 1)).reshape(N_KV_HEADS, GQA_GROUP, ATT_BLOCK, 2 * ATT_BLOCK)
    key_pos = jnp.arange(nb)[:, None, None] * ATT_BLOCK - ATT_BLOCK + kj[None]
    valid = ((dist >= 0) & (dist < WINDOW))[None] & (key_pos >= 0)
    logits = jnp.where(valid[None, :, None, None], logits + bias.astype(jnp.float32), NEG_INF)

    sink = jnp.broadcast_to(sinks.reshape(N_KV_HEADS, GQA_GROUP, 1, 1).astype(jnp.float32),
                            logits.shape[:-1] + (1,))
    probs = jax.nn.softmax(jnp.concatenate([logits, sink], axis=-1), axis=-1)[..., :-1]
    out = jnp.einsum('bnhgqk,bnkhd->bnqhgd', probs, vw)
    return out.reshape(B, S, ATT_Q_W)


def setup_inputs(seed: int = 0) -> dict:
    key = jax.random.key(seed)
    ks = jax.random.split(key, 32)
    f = jnp.float32
    nrm = lambda i, shape, s: jax.random.normal(ks[i], shape, f) * s
    return {
        "x": nrm(0, (BATCH, SEQ, D_MODEL), 1.0),
        "c": nrm(1, (BATCH, D_MODEL), 1.0),
        "w_ada": nrm(2, (D_MODEL, N_MOD * D_MODEL), 0.5 * D_MODEL ** -0.5),
        "b_ada": nrm(3, (N_MOD * D_MODEL,), 0.01),
        "norm1_g": 1.0 + nrm(4, (D_MODEL,), 0.02),
        "w_in": nrm(5, (D_MODEL, IN_COLS), D_MODEL ** -0.5),
        "rwkv_mu": jax.random.uniform(ks[6], (RWKV_COLS,), f),
        "w0": nrm(7, (RWKV_W,), 0.5),
        "w_lora_up": nrm(8, (DECAY_LORA, RWKV_W), 0.5 * DECAY_LORA ** -0.5),
        "a0": nrm(9, (RWKV_W,), 0.1),
        "a_lora_up": nrm(10, (AAA_LORA, RWKV_W), 0.5 * AAA_LORA ** -0.5),
        "g_lora_up": nrm(11, (GATE_LORA, RWKV_W), GATE_LORA ** -0.5),
        "k_k": 0.85 + nrm(12, (RWKV_W,), 0.02),
        "k_a": 1.0 + nrm(13, (RWKV_W,), 0.02),
        "r_k": nrm(14, (RWKV_HEADS, HEAD_DIM), 0.1),
        "lnx_g": 1.0 + nrm(15, (RWKV_W,), 0.02),
        "lnx_b": nrm(16, (RWKV_W,), 0.01),
        "q_norm_g": 1.0 + nrm(17, (HEAD_DIM,), 0.02),
        "k_norm_g": 1.0 + nrm(18, (HEAD_DIM,), 0.02),
        "sinks": nrm(19, (N_Q_HEADS,), 0.5),
        "rel_bias": nrm(20, (NUM_BUCKETS, N_Q_HEADS), 0.5),
        "w_out": nrm(21, (MIX_W, D_MODEL), MIX_W ** -0.5),
        "norm2_g": 1.0 + nrm(22, (D_MODEL,), 0.02),
        "w_gate": nrm(23, (D_MODEL, D_FF), D_MODEL ** -0.5),
        "w_up": nrm(24, (D_MODEL, D_FF), D_MODEL ** -0.5),
        "w_down": nrm(25, (D_FF, D_MODEL), D_FF ** -0.5),
    }


def reference(x, c, w_ada, b_ada, norm1_g, w_in, rwkv_mu, w0, w_lora_up, a0, a_lora_up,
              g_lora_up, k_k, k_a, r_k, lnx_g, lnx_b, q_norm_g, k_norm_g, sinks, rel_bias,
              w_out, norm2_g, w_gate, w_up, w_down):
    out_dtype = x.dtype
    h_res = x.astype(jnp.float32)
    mod = jax.nn.silu(c.astype(jnp.float32)) @ w_ada + b_ada
    shift1, scale1, gate1, shift2, scale2, gate2 = [m[:, None, :] for m in jnp.split(mod, N_MOD, axis=-1)]

    for _ in range(DEPTH):
        h = rmsnorm(h_res, norm1_g) * (1.0 + scale1) + shift1
        proj = h @ w_in
        y_rwkv = rwkv7_group(proj[..., :RWKV_COLS], rwkv_mu, w0, w_lora_up, a0, a_lora_up,
                             g_lora_up, k_k, k_a, r_k, lnx_g, lnx_b)
        y_att = swa_group(proj[..., RWKV_COLS:], q_norm_g, k_norm_g, sinks, rel_bias)
        mix = jnp.concatenate([y_rwkv, y_att], axis=-1) @ w_out
        h_res = h_res + gate1 * mix
        h2 = rmsnorm(h_res, norm2_g) * (1.0 + scale2) + shift2
        ffn = (jax.nn.silu(h2 @ w_gate) * (h2 @ w_up)) @ w_down
        h_res = h_res + gate2 * ffn

    return h_res.astype(out_dtype)
```

```cpp
#include <hip/hip_runtime.h>
#include <hip/hip_cooperative_groups.h>
#include <cstdio>
#include <cstdint>
#include <cstring>
namespace pg8 {
#define PG8_LAS __attribute__((address_space(3)))
typedef unsigned short bf16_t;
typedef short bf16x8 __attribute__((ext_vector_type(8)));
typedef float f32x4 __attribute__((ext_vector_type(4)));
typedef unsigned u32x4 __attribute__((ext_vector_type(4)));
constexpr int BM = 256, BK = 64, HALF = 128, HTB = HALF * BK * 2  , STAGE_BYTES = 8 * HTB, NXCD = 8, WGM = 8;

__host__ __device__ __forceinline__ int lds_byte(int r, int c) { const int st = (r >> 4) * 2 + (c >> 5), rr = r & 15, cc = c & 31, ob = rr * 64 + cc * 2; return st * 1024 + (ob ^ (((ob >> 9) & 1) << 5)); }
__host__ __device__ __forceinline__ void stage_rc(int b, int& R, int& C) { const int st = b / 1024, sb = b % 1024, swz = sb ^ (((sb >> 9) & 1) << 5); R = (st >> 1) * 16 + swz / 64; C = (st & 1) * 32 + (swz % 64) / 2; }
__host__ __device__ __forceinline__ int perm32(int rho) { const int n = rho >> 4, i = rho & 15; return 8 * (i >> 2) + 4 * n + (i & 3); }

struct Unit { int pm, pn; };
struct Gemm { const bf16_t* A; const bf16_t* Bt; int M, N, K, pad; size_t bstride; };

struct StaticOrder {
    int nM, nN, nwg, G, c, wgm;
    __host__ __device__ void init(int M, int N, int G_, int c_, int wgm_ = WGM) { nM = M / BM; nN = N / BM; nwg = nM * nN; G = G_; c = c_; wgm = wgm_; }
    __host__ __device__ bool next(int i, Unit& u) const {
        const long L = (long)i * G + c; if (L >= nwg) return false;
        int wgid = (int)L; { const int q = nwg / NXCD, r = nwg % NXCD, xcd = wgid % NXCD, off = wgid / NXCD; wgid = (xcd < r ? xcd * (q + 1) : r * (q + 1) + (xcd - r) * q) + off; }
        const int nig = wgm * nN, gid = wgid / nig, fm = gid * wgm, gsz = (nM - fm) < wgm ? (nM - fm) : wgm;
        u.pm = fm + ((wgid % nig) % gsz); u.pn = (wgid % nig) / gsz; return true;
    }
    __device__ __forceinline__ void a_ready(const Unit&) const {}
    __device__ __forceinline__ void done(const Unit&) const {}
};

__device__ __forceinline__ unsigned cvt_pk_bf16(float lo, float hi) { unsigned r; asm volatile("v_cvt_pk_bf16_f32 %0, %1, %2" : "=v"(r) : "v"(lo), "v"(hi)); return r; }
template <class Epi, class Sched, bool ALIGN_EPI = false, bool SP2 = false>
__device__ __forceinline__ void gemm_phase(PG8_LAS unsigned char* lds, const Gemm g, const Sched& S, const Epi& E, const int wv) {
    int lane__; asm volatile("v_mbcnt_lo_u32_b32 %0, -1, 0\n\tv_mbcnt_hi_u32_b32 %0, -1, %0" : "=v"(lane__)); const int tid_ = wv * 64 + lane__;
    const int tid = tid_, wid = __builtin_amdgcn_readfirstlane(tid >> 6), lane = tid & 63, wr = wid >> 2, wc = wid & 3, fr = lane & 15, fq = lane >> 4;
    const int K = g.K, nt = K / BK;
    unsigned voffA[2], voffB[2];
#pragma unroll
    for (int i = 0; i < 2; ++i) { int R, C; stage_rc(tid * 16 + i * 8192, R, C); const int Rb = Epi::PERM ? ((R & ~31) + perm32(R & 31)) : R;
        voffA[i] = (unsigned)(R * K + C) * 2u; voffB[i] = (unsigned)(Rb * K + C) * 2u; }
    const size_t kstep = (size_t)(BK * 2);
    const size_t hstep = (size_t)HALF * K * 2;
    const size_t tstep = 2 * hstep;
    const unsigned ldsw = (unsigned)wid * 1024u;
    const int aoff = lds_byte(wr * 64 + fr, fq * 8), boff = lds_byte(wc * 32 + fr, fq * 8);
#define PG8_SA(b, h) (((b) * 2 + (h)) * HTB)
#define PG8_SB(b, h) ((4 + (b) * 2 + (h)) * HTB)
#define PG8_STAGE(bufoff, gbase, voff) do { _Pragma("unroll") for (int _i = 0; _i < 2; ++_i) \
        __builtin_amdgcn_global_load_lds((const unsigned*)((const char*)(gbase) + (voff)[_i]), (PG8_LAS unsigned*)(lds + (bufoff) + ldsw + _i * 8192), 16, 0, 0); } while (0)
#define PG8_LDA(dst, b, h) do { _Pragma("unroll") for (int m = 0; m < 4; ++m) _Pragma("unroll") for (int k = 0; k < 2; ++k) dst[m][k] = *(const PG8_LAS bf16x8*)(lds + PG8_SA(b, h) + aoff + m * 2048 + k * 1024); } while (0)
#define PG8_LDB(dst, b, h) do { _Pragma("unroll") for (int n = 0; n < 2; ++n) _Pragma("unroll") for (int k = 0; k < 2; ++k) dst[n][k] = *(const PG8_LAS bf16x8*)(lds + PG8_SB(b, h) + boff + n * 2048 + k * 1024); } while (0)
#define PG8_MMA(ai, bj, At, Bt) do { __builtin_amdgcn_s_setprio(1); _Pragma("unroll") for (int m = 0; m < 4; ++m) _Pragma("unroll") for (int n = 0; n < 2; ++n) _Pragma("unroll") for (int k = 0; k < 2; ++k) \
        acc[ai][bj][m][n] = __builtin_amdgcn_mfma_f32_16x16x32_bf16(Bt[n][k], At[m][k], acc[ai][bj][m][n], 0, 0, 0); __builtin_amdgcn_s_setprio(0); } while (0)
#define PG8_WAIT_V(n) asm volatile("s_waitcnt vmcnt(" #n ")" ::: "memory")
#define PG8_WAIT_L(n) asm volatile("s_waitcnt lgkmcnt(" #n ")" ::: "memory")
#define PG8_BAR __builtin_amdgcn_s_barrier()
#define PG8_SCHED __builtin_amdgcn_sched_barrier(0)
    Unit cur, nxt; int ui = 0;
    if (!S.next(0, cur)) return;
    f32x4 acc[2][2][4][2];
#pragma unroll
    for (int a = 0; a < 2; ++a)
#pragma unroll
        for (int b = 0; b < 2; ++b)
#pragma unroll
            for (int m = 0; m < 4; ++m)
#pragma unroll
                for (int n = 0; n < 2; ++n) acc[a][b][m][n] = (f32x4){0.f, 0.f, 0.f, 0.f};
    bf16x8 At[4][2], B0[2][2], B1[2][2];
    const char* cA = (const char*)g.A + (size_t)cur.pm * tstep; const char* cB = (const char*)g.Bt + (size_t)cur.pn * tstep + (size_t)(cur.pm >> 5) * g.bstride;
    S.a_ready(cur);
    if constexpr (SP2) {
        PG8_STAGE(PG8_SB(0, 0), cB, voffB); PG8_STAGE(PG8_SB(0, 1), cB + hstep, voffB); PG8_STAGE(PG8_SA(0, 0), cA, voffA); PG8_STAGE(PG8_SA(0, 1), cA + hstep, voffA);
        if (wr == 1) PG8_BAR;
        PG8_WAIT_V(2); PG8_BAR;
        PG8_STAGE(PG8_SB(1, 0), cB + kstep, voffB); PG8_STAGE(PG8_SA(1, 0), cA + kstep, voffA); PG8_STAGE(PG8_SB(1, 1), cB + hstep + kstep, voffB);
        PG8_WAIT_V(6); PG8_BAR;
    } else {
        PG8_STAGE(PG8_SB(0, 0), cB, voffB); PG8_STAGE(PG8_SA(0, 0), cA, voffA); PG8_STAGE(PG8_SB(0, 1), cB + hstep, voffB); PG8_STAGE(PG8_SA(0, 1), cA + hstep, voffA);
        if (wr == 1) PG8_BAR;
        PG8_WAIT_V(4); PG8_BAR;
        PG8_STAGE(PG8_SB(1, 0), cB + kstep, voffB); PG8_STAGE(PG8_SA(1, 0), cA + kstep, voffA); PG8_STAGE(PG8_SB(1, 1), cB + hstep + kstep, voffB);
        PG8_WAIT_V(6); PG8_BAR;
    }
    for (;;) {
        const bool has_next = S.next(ui + 1, nxt);
        const char* nA = has_next ? (const char*)g.A + (size_t)nxt.pm * tstep : cA; const char* nB = has_next ? (const char*)g.Bt + (size_t)nxt.pn * tstep + (size_t)(nxt.pm >> 5) * g.bstride : cB;
        for (int t = 0; t < nt; t += 2) {
            const bool last = (t == nt - 2);
            const char* a1 = cA + (size_t)(t + 1) * kstep;
            const char* a2 = last ? nA : cA + (size_t)(t + 2) * kstep; const char* b2 = last ? nB : cB + (size_t)(t + 2) * kstep;
            const char* a3 = a2 + kstep; const char* b3 = b2 + kstep;
            if (last && has_next) S.a_ready(nxt);
            if constexpr (SP2) {
            PG8_LDB(B0, 0, 0); PG8_LDB(B1, 0, 1); PG8_SCHED; PG8_LDA(At, 0, 0); PG8_STAGE(PG8_SA(1, 1), a1 + hstep, voffA);
            PG8_WAIT_V(8); PG8_WAIT_L(0); PG8_BAR; PG8_MMA(0, 0, At, B0); PG8_MMA(0, 1, At, B1); PG8_BAR; PG8_SCHED;
            PG8_LDA(At, 0, 1); PG8_STAGE(PG8_SB(0, 0), b2, voffB); PG8_STAGE(PG8_SB(0, 1), b2 + hstep, voffB); PG8_STAGE(PG8_SA(0, 0), a2, voffA);
            PG8_WAIT_V(8); PG8_WAIT_L(0); PG8_BAR; PG8_MMA(1, 0, At, B0); PG8_MMA(1, 1, At, B1); PG8_BAR; PG8_SCHED;
            PG8_LDB(B0, 1, 0); PG8_LDB(B1, 1, 1); PG8_SCHED; PG8_LDA(At, 1, 0); PG8_STAGE(PG8_SA(0, 1), a2 + hstep, voffA);
            PG8_WAIT_V(8); PG8_WAIT_L(0); PG8_BAR; PG8_MMA(0, 0, At, B0); PG8_MMA(0, 1, At, B1); PG8_BAR; PG8_SCHED;
            PG8_LDA(At, 1, 1); PG8_STAGE(PG8_SB(1, 0), b3, voffB); PG8_STAGE(PG8_SB(1, 1), b3 + hstep, voffB); PG8_STAGE(PG8_SA(1, 0), a3, voffA);
            PG8_WAIT_V(8); PG8_WAIT_L(0); PG8_BAR; PG8_MMA(1, 0, At, B0); PG8_MMA(1, 1, At, B1); PG8_BAR; PG8_SCHED;
            } else {
            PG8_LDB(B0, 0, 0); PG8_SCHED; PG8_LDA(At, 0, 0); PG8_STAGE(PG8_SA(1, 1), a1 + hstep, voffA);
            PG8_WAIT_L(8); PG8_BAR; PG8_WAIT_L(0); PG8_MMA(0, 0, At, B0); PG8_BAR; PG8_SCHED;
            PG8_LDB(B1, 0, 1); PG8_STAGE(PG8_SB(0, 0), b2, voffB);
            PG8_BAR; PG8_WAIT_L(0); PG8_MMA(0, 1, At, B1); PG8_BAR;
            PG8_LDA(At, 0, 1); PG8_STAGE(PG8_SA(0, 0), a2, voffA);
            PG8_BAR; PG8_WAIT_L(0); PG8_MMA(1, 0, At, B0); PG8_BAR; PG8_SCHED;
            PG8_STAGE(PG8_SB(0, 1), b2 + hstep, voffB);
            PG8_WAIT_V(6); PG8_BAR; PG8_MMA(1, 1, At, B1); PG8_BAR;
            PG8_LDB(B0, 1, 0); PG8_SCHED; PG8_LDA(At, 1, 0); PG8_STAGE(PG8_SA(0, 1), a2 + hstep, voffA);
            PG8_WAIT_L(8); PG8_BAR; PG8_WAIT_L(0); PG8_MMA(0, 0, At, B0); PG8_BAR; PG8_SCHED;
            PG8_LDB(B1, 1, 1); PG8_STAGE(PG8_SB(1, 0), b3, voffB);
            PG8_BAR; PG8_WAIT_L(0); PG8_MMA(0, 1, At, B1); PG8_BAR;
            PG8_LDA(At, 1, 1); PG8_STAGE(PG8_SA(1, 0), a3, voffA);
            PG8_BAR; PG8_WAIT_L(0); PG8_MMA(1, 0, At, B0); PG8_BAR; PG8_SCHED;
            PG8_STAGE(PG8_SB(1, 1), b3 + hstep, voffB);
            PG8_WAIT_V(6); PG8_BAR; PG8_MMA(1, 1, At, B1); PG8_BAR;
            }
        }
        if constexpr (ALIGN_EPI) { if (wr == 0) PG8_BAR; }
        if constexpr (!Epi::AFTER_DRAIN) { E(acc, cur, wr, wc, fr, fq); S.done(cur); }
        if (!has_next) break;
#pragma unroll
        for (int a = 0; a < 2; ++a)
#pragma unroll
            for (int b = 0; b < 2; ++b)
#pragma unroll
                for (int m = 0; m < 4; ++m)
#pragma unroll
                    for (int n = 0; n < 2; ++n) acc[a][b][m][n] = (f32x4){0.f, 0.f, 0.f, 0.f};
        cur = nxt; cA = nA; cB = nB; ++ui;
        if constexpr (ALIGN_EPI) { if (wr == 1) PG8_BAR; }
    }
    PG8_WAIT_V(0);
    if constexpr (!ALIGN_EPI) { if (wr == 0) PG8_BAR; }
    PG8_BAR;
    if constexpr (Epi::AFTER_DRAIN) { E.fused(acc, cur, wr, wc, fr, fq, lds, wid, lane); S.done(cur); }
#undef PG8_SA
#undef PG8_SB
#undef PG8_STAGE
#undef PG8_LDA
#undef PG8_LDB
#undef PG8_MMA
#undef PG8_WAIT_V
#undef PG8_WAIT_L
#undef PG8_BAR
#undef PG8_SCHED
}
}

constexpr int BATCH = 4, SEQ = 8192, NTOK = BATCH * SEQ, DM = 1024, INC = 2560, RW = 512, RCOLS = 1792, DFF = 2816, NMOD = 6 * DM;
constexpr float NORM_EPS = 1e-6f, GN_EPS = 64e-5f;
typedef unsigned short bf16;
typedef float f32x4 __attribute__((ext_vector_type(4)));
typedef unsigned u32x4 __attribute__((ext_vector_type(4)));
typedef unsigned u32x2 __attribute__((ext_vector_type(2)));
#define LAS __attribute__((address_space(3)))

typedef float f32x2_t __attribute__((ext_vector_type(2))); typedef __bf16 bf16x2_t __attribute__((ext_vector_type(2)));
__device__ __forceinline__ unsigned pk2(float lo, float hi) { f32x2_t v = {lo, hi}; bf16x2_t b = __builtin_convertvector(v, bf16x2_t); return __builtin_bit_cast(unsigned, b); }
__device__ __forceinline__ unsigned f2bf(float f) { return pk2(f, 0.f) & 0xffffu; }
__device__ __forceinline__ int lane_fresh() { int l; asm volatile("v_mbcnt_lo_u32_b32 %0, -1, 0\n\tv_mbcnt_hi_u32_b32 %0, -1, %0" : "=v"(l)); return l; }
__device__ __forceinline__ float bf2f(bf16 v) { return __builtin_bit_cast(float, (unsigned)v << 16); }
__device__ __forceinline__ float rows_sum(float v) {
    auto a = __builtin_amdgcn_permlane16_swap(__builtin_bit_cast(unsigned, v), __builtin_bit_cast(unsigned, v), false, false);
    v = __builtin_bit_cast(float, a[0]) + __builtin_bit_cast(float, a[1]);
    auto b = __builtin_amdgcn_permlane32_swap(__builtin_bit_cast(unsigned, v), __builtin_bit_cast(unsigned, v), false, false);
    return __builtin_bit_cast(float, b[0]) + __builtin_bit_cast(float, b[1]);
}
__device__ __forceinline__ float wave_sum(float v) {
#pragma unroll
    for (int o = 1; o < 64; o <<= 1) v += __shfl_xor(v, o);
    return v;
}
__device__ __forceinline__ float sigmoidf_(float x) { return 1.0f / (1.0f + expf(-x)); }
__device__ __forceinline__ float siluf_(float x) { return x / (1.0f + expf(-x)); }
__device__ __forceinline__ float softplusf_(float x) { return fmaxf(x, 0.f) + log1pf(expf(-fabsf(x))); }

__constant__ unsigned char T5B[128] = {0, 1, 2, 3, 4, 5, 6, 7, 8, 9, 10, 11, 12, 13, 14, 15, 16, 16, 16, 17, 17, 18, 18, 18, 19, 19, 19, 20, 20, 20, 20, 21, 21, 21, 21, 22, 22, 22, 22, 22, 23, 23, 23, 23, 23, 23, 24, 24, 24, 24, 24, 24, 25, 25, 25, 25, 25, 25, 25, 26, 26, 26, 26, 26, 26, 26, 26, 27, 27, 27, 27, 27, 27, 27, 27, 27, 27, 28, 28, 28, 28, 28, 28, 28, 28, 28, 28, 29, 29, 29, 29, 29, 29, 29, 29, 29, 29, 29, 29, 30, 30, 30, 30, 30, 30, 30, 30, 30, 30, 30, 30, 30, 30, 31, 31, 31, 31, 31, 31, 31, 31, 31, 31, 31, 31, 31, 31, 31};

constexpr size_t MiB = 1u << 20;
constexpr size_t WS_CTL = 0, CTL_ZERO_BYTES = 1 * MiB;
constexpr size_t WS_MOD = 256 * 1024;
constexpr size_t WS_SSQ = 512 * 1024;
constexpr size_t WS_CGU = 640 * 1024;
constexpr size_t WS_WIN = 2 * MiB;
constexpr size_t WS_WOUT = 22 * MiB;
constexpr size_t WS_WGU = 24 * MiB;
constexpr size_t WS_WDN = 68 * MiB;
constexpr size_t WS_C1 = 832 * 1024;
constexpr size_t WS_RSTD1 = 1 * MiB;
constexpr size_t WS_PAR = 768 * 1024;
constexpr int PO_MU = 0, PO_W0 = 1792, PO_A0 = 2304, PO_KK = 2816, PO_KA = 3328, PO_RK = 3840, PO_LG = 4352, PO_LB = 4864, PO_QG = 5376, PO_KG = 5440, PO_SINK = 5504, PO_RB = 5512, PO_N1 = 5768, PO_N2 = 6792;
constexpr size_t WS_LORA = 74 * MiB;
constexpr size_t WS_XB = 76 * MiB;
constexpr size_t WS_PROJ = 140 * MiB;
constexpr size_t WS_YMIX = 300 * MiB;
constexpr size_t WS_H2 = 364 * MiB;
constexpr size_t WS_PRE = 428 * MiB;
constexpr size_t WS_BON = 492 * MiB;
constexpr size_t WS_END = 494 * MiB;
#define XB_TMO      128
#define XB_XCNT(j)  (256  + 64 * (j))
#define XB_XSUB(j)  (1280 + 64 * (j))
#define XB_XGEN(j)  (2304 + 64 * (j))
#define XB_TOP      3328
#define XB_TOPGEN   3392
#define XCD_BAR_WORDS 3456
#define XB_SPIN_CAP (1u << 18)


__device__ __forceinline__ unsigned xb_ld(unsigned* p)              { return __hip_atomic_load(p, __ATOMIC_RELAXED, __HIP_MEMORY_SCOPE_AGENT); }
__device__ __forceinline__ unsigned xb_add(unsigned* p, unsigned v) { return __hip_atomic_fetch_add(p, v, __ATOMIC_RELAXED, __HIP_MEMORY_SCOPE_AGENT); }
__device__ __forceinline__ unsigned xb_xcc_id() { return (unsigned)__builtin_amdgcn_s_getreg((3 << 11) | 20) & 0xFu; }
#define XB_SPIN(cond, bar) do { unsigned _sp = 0; while (cond) { __builtin_amdgcn_s_sleep(1); \
    if ((++_sp & 255u) == 0u) { if (xb_ld(&(bar)[XB_TMO])) break; if (_sp > XB_SPIN_CAP) { atomicAdd(&(bar)[XB_TMO], 1u); break; } } } } while (0)

struct XcdBarrier {
    int wv;
    unsigned* bar; unsigned x;
    volatile LAS unsigned* st;
};

__device__ __forceinline__ XcdBarrier xcd_barrier_post(unsigned* bar, volatile LAS unsigned* st, int wv) {
    XcdBarrier b; b.wv = wv; b.bar = bar; b.x = xb_xcc_id(); b.st = st;
    if (wv == 0 && lane_fresh() == 0) (void)xb_add(&bar[XB_XCNT(b.x)], 1u);
    return b;
}
__device__ __forceinline__ void xcd_barrier_complete(unsigned* bar, unsigned x, unsigned& nloc, unsigned& nx) {
    const unsigned G = gridDim.x * gridDim.y * gridDim.z;
    unsigned sum, cnt, mine, sp = 0u;
    for (;;) {
        sum = 0u; cnt = 0u; mine = 0u;
#pragma unroll
        for (unsigned j = 0; j < 16; ++j) { const unsigned c = xb_ld(&bar[XB_XCNT(j)]); sum += c; cnt += (c > 0u) ? 1u : 0u; mine = (j == x) ? c : mine; }
        if (sum == G) break;
        __builtin_amdgcn_s_sleep(1);
        if ((++sp & 255u) == 0u) { if (xb_ld(&bar[XB_TMO])) break; if (sp > XB_SPIN_CAP) { atomicAdd(&bar[XB_TMO], 1u); break; } }
    }
    nloc = mine > 0u ? mine : 1u; nx = cnt > 0u ? cnt : 1u;
}

__device__ __forceinline__ void xcd_barrier(const XcdBarrier& b) {
    asm volatile("s_waitcnt vmcnt(0)" ::: "memory");
    __syncthreads();
    if (b.wv == 0 && lane_fresh() == 0) {
        unsigned* bar = b.bar;
        __builtin_amdgcn_s_waitcnt(0);
        unsigned nloc = b.st[0], nx = b.st[1];
        if (nloc == 0u) { xcd_barrier_complete(bar, b.x, nloc, nx); b.st[0] = nloc; b.st[1] = nx; }
        const unsigned old = xb_add(&bar[XB_XSUB(b.x)], 1u);
        const unsigned gen = old / nloc;
        if (old + 1u == (gen + 1u) * nloc) {
            __builtin_amdgcn_fence(__ATOMIC_RELEASE, "agent");
            asm volatile("s_waitcnt vmcnt(0)" ::: "memory");
            const unsigned og = xb_add(&bar[XB_TOP], 1u);
            const unsigned tg = og / nx;
            if (og + 1u == (tg + 1u) * nx) xb_add(&bar[XB_TOPGEN], 1u);
            else XB_SPIN(xb_ld(&bar[XB_TOPGEN]) == tg, bar);
            __builtin_amdgcn_fence(__ATOMIC_ACQUIRE, "agent");
            xb_add(&bar[XB_XGEN(b.x)], 1u);
            asm volatile("s_waitcnt vmcnt(0)" ::: "memory");
        } else {
            XB_SPIN(xb_ld(&bar[XB_XGEN(b.x)]) == gen, bar);
            __builtin_amdgcn_fence(__ATOMIC_ACQUIRE, "agent");
            asm volatile("s_waitcnt vmcnt(0)" ::: "memory");
        }
    }
    __syncthreads();
}
using pg8::Unit;
struct EpiStoreBf16 {
    static constexpr bool PERM = true, AFTER_DRAIN = false;
    bf16* O; int ldc; int pad;
    __device__ __forceinline__ void operator()(const f32x4 (&acc)[2][2][4][2], const Unit& u, int wr, int wc, int fr, int fq) const {
        const int row0 = u.pm * 256 + wr * 64 + fr, col0 = u.pn * 256 + wc * 32 + 8 * fq;
#pragma unroll
        for (int ai = 0; ai < 2; ++ai)
#pragma unroll
            for (int m = 0; m < 4; ++m) { bf16* rowp = O + (size_t)(row0 + ai * 128 + m * 16) * ldc + col0;
#pragma unroll
                for (int bj = 0; bj < 2; ++bj) { const f32x4 v0 = acc[ai][bj][m][0], v1 = acc[ai][bj][m][1]; u32x4 w;
                    w.x = pg8::cvt_pk_bf16(v0[0], v0[1]); w.y = pg8::cvt_pk_bf16(v0[2], v0[3]); w.z = pg8::cvt_pk_bf16(v1[0], v1[1]); w.w = pg8::cvt_pk_bf16(v1[2], v1[3]);
                    *(u32x4*)(rowp + bj * 128) = w; } }
    }
};
struct EpiResid {
    static constexpr bool PERM = false, AFTER_DRAIN = false;
    const float* base; float* out; const float* gate;
    __device__ __forceinline__ void operator()(const f32x4 (&acc)[2][2][4][2], const Unit& u, int wr, int wc, int fr, int fq) const {
        const int b = u.pm >> 5, col0 = u.pn * 256 + wc * 32 + 4 * fq;
#pragma unroll
        for (int bj = 0; bj < 2; ++bj)
#pragma unroll
            for (int n = 0; n < 2; ++n) { const f32x4 gv = *(const f32x4*)(gate + b * NMOD + col0 + bj * 128 + n * 16);
#pragma unroll
                for (int ai = 0; ai < 2; ++ai)
#pragma unroll
                    for (int m = 0; m < 4; ++m) { const size_t off = (size_t)(u.pm * 256 + ai * 128 + wr * 64 + m * 16 + fr) * DM + col0 + bj * 128 + n * 16;
                        const f32x4 bs = *(const f32x4*)(base + off); *(f32x4*)(out + off) = bs + gv * acc[ai][bj][m][n]; } }
    }
};
struct EpiSwiglu {
    static constexpr bool PERM = true, AFTER_DRAIN = false;
    bf16* act;
    __device__ __forceinline__ void operator()(const f32x4 (&acc)[2][2][4][2], const Unit& u, int wr, int wc, int fr, int fq) const {
        const int row0 = u.pm * 256 + wr * 64 + fr, col0 = u.pn * 128 + wc * 32 + 8 * fq;
#pragma unroll
        for (int ai = 0; ai < 2; ++ai)
#pragma unroll
            for (int m = 0; m < 4; ++m) { const f32x4 g0 = acc[ai][0][m][0], g1 = acc[ai][0][m][1], u0 = acc[ai][1][m][0], u1 = acc[ai][1][m][1]; float r[8];
#pragma unroll
                for (int e = 0; e < 4; ++e) { r[e] = g0[e] * __builtin_amdgcn_rcpf(1.0f + __builtin_amdgcn_exp2f(-1.4426950408889634f * g0[e])) * u0[e]; r[4 + e] = g1[e] * __builtin_amdgcn_rcpf(1.0f + __builtin_amdgcn_exp2f(-1.4426950408889634f * g1[e])) * u1[e]; }
                u32x4 w; w.x = pg8::cvt_pk_bf16(r[0], r[1]); w.y = pg8::cvt_pk_bf16(r[2], r[3]); w.z = pg8::cvt_pk_bf16(r[4], r[5]); w.w = pg8::cvt_pk_bf16(r[6], r[7]);
                *(u32x4*)(act + (size_t)(row0 + ai * 128 + m * 16) * DFF + col0) = w; }
    }
};


struct EpiResidNorm {
    static constexpr bool PERM = false, AFTER_DRAIN = false;
    const float* base; float* out; const float* gate; bf16* hb; float* ssq;
    __device__ __forceinline__ void operator()(const f32x4 (&acc)[2][2][4][2], const Unit& u, int wr, int wc, int fr, int fq) const {
        const int b = u.pm >> 5, col0 = u.pn * 256 + wc * 32 + 4 * fq;
        f32x4 gv[2][2];
#pragma unroll
        for (int bj = 0; bj < 2; ++bj)
#pragma unroll
            for (int n = 0; n < 2; ++n) gv[bj][n] = *(const f32x4*)(gate + b * NMOD + col0 + bj * 128 + n * 16);
#pragma unroll
        for (int ai = 0; ai < 2; ++ai)
#pragma unroll
            for (int m = 0; m < 4; ++m) {
                const int row = u.pm * 256 + ai * 128 + wr * 64 + m * 16 + fr; float sq = 0.f;
#pragma unroll
                for (int bj = 0; bj < 2; ++bj)
#pragma unroll
                    for (int n = 0; n < 2; ++n) { const size_t off = (size_t)row * DM + col0 + bj * 128 + n * 16;
                        const f32x4 hv = *(const f32x4*)(base + off) + gv[bj][n] * acc[ai][bj][m][n];
                        *(f32x4*)(out + off) = hv;
                        u32x2 w; w.x = pg8::cvt_pk_bf16(hv[0], hv[1]); w.y = pg8::cvt_pk_bf16(hv[2], hv[3]); *(u32x2*)(hb + off) = w;
                        sq += (hv[0] * hv[0] + hv[1] * hv[1]) + (hv[2] * hv[2] + hv[3] * hv[3]); }
                sq += __shfl_xor(sq, 16); sq += __shfl_xor(sq, 32);
                if (fq == 0) atomicAdd(ssq + row, sq);
            }
    }
};
struct EpiSwigluNorm {
    static constexpr bool PERM = true, AFTER_DRAIN = false;
    bf16* act; const float* ssq; const float* cgu;
    __device__ __forceinline__ void operator()(const f32x4 (&acc)[2][2][4][2], const Unit& u, int wr, int wc, int fr, int fq) const {
        const int row0 = u.pm * 256 + wr * 64 + fr, col0 = u.pn * 128 + wc * 32 + 8 * fq, b = u.pm >> 5;
        const float* cg = cgu + (size_t)b * (2 * DFF) + u.pn * 256 + wc * 32 + 8 * fq;
        const f32x4 cg0 = *(const f32x4*)(cg), cg1 = *(const f32x4*)(cg + 4), cu0 = *(const f32x4*)(cg + 128), cu1 = *(const f32x4*)(cg + 132);
#pragma unroll
        for (int ai = 0; ai < 2; ++ai)
#pragma unroll
            for (int m = 0; m < 4; ++m) { const int row = row0 + ai * 128 + m * 16;
                const float rstd = 1.0f / sqrtf(ssq[row] * (1.f / DM) + NORM_EPS);
                const f32x4 g0 = acc[ai][0][m][0] * rstd + cg0, g1 = acc[ai][0][m][1] * rstd + cg1, u0 = acc[ai][1][m][0] * rstd + cu0, u1 = acc[ai][1][m][1] * rstd + cu1; float r[8];
#pragma unroll
                for (int e = 0; e < 4; ++e) { r[e] = g0[e] * __builtin_amdgcn_rcpf(1.0f + __builtin_amdgcn_exp2f(-1.4426950408889634f * g0[e])) * u0[e]; r[4 + e] = g1[e] * __builtin_amdgcn_rcpf(1.0f + __builtin_amdgcn_exp2f(-1.4426950408889634f * g1[e])) * u1[e]; }
                u32x4 w; w.x = pg8::cvt_pk_bf16(r[0], r[1]); w.y = pg8::cvt_pk_bf16(r[2], r[3]); w.z = pg8::cvt_pk_bf16(r[4], r[5]); w.w = pg8::cvt_pk_bf16(r[6], r[7]);
                __builtin_nontemporal_store(w, (u32x4*)(act + (size_t)row * DFF + col0)); }
    }
};

struct EpiResidNormB {
    static constexpr bool PERM = true, AFTER_DRAIN = false;
    const bf16* base; const float* gate; bf16* hb; float* ssq;
    __device__ __forceinline__ void operator()(const f32x4 (&acc)[2][2][4][2], const Unit& u, int wr, int wc, int fr, int fq) const {
        const int b = u.pm >> 5, col0 = u.pn * 256 + wc * 32 + 8 * fq;
        f32x4 gv[2][2];
#pragma unroll
        for (int bj = 0; bj < 2; ++bj)
#pragma unroll
            for (int n = 0; n < 2; ++n) gv[bj][n] = *(const f32x4*)(gate + b * NMOD + col0 + bj * 128 + n * 4);
#pragma unroll
        for (int ai = 0; ai < 2; ++ai)
#pragma unroll
            for (int m = 0; m < 4; ++m) {
                const int row = u.pm * 256 + ai * 128 + wr * 64 + m * 16 + fr; float sq = 0.f;
#pragma unroll
                for (int bj = 0; bj < 2; ++bj) { const size_t off = (size_t)row * DM + col0 + bj * 128;
                    const u32x4 xv = __builtin_nontemporal_load((const u32x4*)(base + off));
                    f32x4 x0, x1; x0[0] = __builtin_bit_cast(float, xv.x << 16); x0[1] = __builtin_bit_cast(float, xv.x & 0xffff0000u); x0[2] = __builtin_bit_cast(float, xv.y << 16); x0[3] = __builtin_bit_cast(float, xv.y & 0xffff0000u);
                    x1[0] = __builtin_bit_cast(float, xv.z << 16); x1[1] = __builtin_bit_cast(float, xv.z & 0xffff0000u); x1[2] = __builtin_bit_cast(float, xv.w << 16); x1[3] = __builtin_bit_cast(float, xv.w & 0xffff0000u);
                    const f32x4 h0 = x0 + gv[bj][0] * acc[ai][bj][m][0], h1 = x1 + gv[bj][1] * acc[ai][bj][m][1];
                    u32x4 w; w.x = pg8::cvt_pk_bf16(h0[0], h0[1]); w.y = pg8::cvt_pk_bf16(h0[2], h0[3]); w.z = pg8::cvt_pk_bf16(h1[0], h1[1]); w.w = pg8::cvt_pk_bf16(h1[2], h1[3]);
                    *(u32x4*)(hb + off) = w;
                    sq += ((h0[0] * h0[0] + h0[1] * h0[1]) + (h0[2] * h0[2] + h0[3] * h0[3])) + ((h1[0] * h1[0] + h1[1] * h1[1]) + (h1[2] * h1[2] + h1[3] * h1[3])); }
                sq += __shfl_xor(sq, 16); sq += __shfl_xor(sq, 32);
                if (fq == 0) atomicAdd(ssq + row, sq);
            }
    }
};
struct EpiFinalB {
    static constexpr bool PERM = true, AFTER_DRAIN = false;
    const bf16* hb; float* out; const float* gate;
    __device__ __forceinline__ void operator()(const f32x4 (&acc)[2][2][4][2], const Unit& u, int wr, int wc, int fr, int fq) const {
        const int b = u.pm >> 5, col0 = u.pn * 256 + wc * 32 + 8 * fq;
        f32x4 gv[2][2];
#pragma unroll
        for (int bj = 0; bj < 2; ++bj)
#pragma unroll
            for (int n = 0; n < 2; ++n) gv[bj][n] = *(const f32x4*)(gate + b * NMOD + col0 + bj * 128 + n * 4);
#pragma unroll
        for (int ai = 0; ai < 2; ++ai)
#pragma unroll
            for (int m = 0; m < 4; ++m) {
                const int row = u.pm * 256 + ai * 128 + wr * 64 + m * 16 + fr;
#pragma unroll
                for (int bj = 0; bj < 2; ++bj) { const size_t off = (size_t)row * DM + col0 + bj * 128;
                    const u32x4 hv = __builtin_nontemporal_load((const u32x4*)(hb + off));
                    f32x4 o0, o1;
                    o0[0] = __builtin_bit_cast(float, hv.x << 16); o0[1] = __builtin_bit_cast(float, hv.x & 0xffff0000u); o0[2] = __builtin_bit_cast(float, hv.y << 16); o0[3] = __builtin_bit_cast(float, hv.y & 0xffff0000u);
                    o1[0] = __builtin_bit_cast(float, hv.z << 16); o1[1] = __builtin_bit_cast(float, hv.z & 0xffff0000u); o1[2] = __builtin_bit_cast(float, hv.w << 16); o1[3] = __builtin_bit_cast(float, hv.w & 0xffff0000u);
                    __builtin_nontemporal_store(o0 + gv[bj][0] * acc[ai][bj][m][0], (f32x4*)(out + off)); __builtin_nontemporal_store(o1 + gv[bj][1] * acc[ai][bj][m][1], (f32x4*)(out + off + 4)); }
            }
    }
};

struct EpiStoreBf16Norm {
    static constexpr bool PERM = true, AFTER_DRAIN = false;
    bf16* O; const float* rstd; const float* cvec; int ldc; int pad;
    __device__ __forceinline__ void operator()(const f32x4 (&acc)[2][2][4][2], const Unit& u, int wr, int wc, int fr, int fq) const {
        const int row0 = u.pm * 256 + wr * 64 + fr, col0 = u.pn * 256 + wc * 32 + 8 * fq, b = u.pm >> 5;
        f32x4 cv[2][2];
#pragma unroll
        for (int bj = 0; bj < 2; ++bj)
#pragma unroll
            for (int n = 0; n < 2; ++n) cv[bj][n] = *(const f32x4*)(cvec + (size_t)b * ldc + col0 + bj * 128 + n * 4);
#pragma unroll
        for (int ai = 0; ai < 2; ++ai)
#pragma unroll
            for (int m = 0; m < 4; ++m) { const int row = row0 + ai * 128 + m * 16; const float rs = rstd[row]; bf16* rowp = O + (size_t)row * ldc + col0;
#pragma unroll
                for (int bj = 0; bj < 2; ++bj) { const f32x4 v0 = acc[ai][bj][m][0] * rs + cv[bj][0], v1 = acc[ai][bj][m][1] * rs + cv[bj][1]; u32x4 w;
                    w.x = pg8::cvt_pk_bf16(v0[0], v0[1]); w.y = pg8::cvt_pk_bf16(v0[2], v0[3]); w.z = pg8::cvt_pk_bf16(v1[0], v1[1]); w.w = pg8::cvt_pk_bf16(v1[2], v1[3]);
                    __builtin_nontemporal_store(w, (u32x4*)(rowp + bj * 128)); } }
    }
};

namespace cg = cooperative_groups;
struct Params {
    const float *x, *c, *w_ada, *b_ada, *norm1_g, *w_in, *rwkv_mu, *w0, *w_lora_up, *a0, *a_lora_up, *g_lora_up, *k_k, *k_a, *r_k, *lnx_g, *lnx_b,
                *q_norm_g, *k_norm_g, *sinks, *rel_bias, *w_out, *norm2_g, *w_gate, *w_up, *w_down;
    float* out; unsigned char* ws;
};
#define LDS_WAIT() asm volatile("s_waitcnt lgkmcnt(0)" ::: "memory")

__device__ __forceinline__ void p_mod(const Params& P, float* mod, float* lds, const int wv) {
    float (*sc)[64] = (float (*)[64])lds;
    const int tid = wv * 64 + lane_fresh();
    for (int it = blockIdx.x; it < 12 * 16; it += gridDim.x) {
        const int nb = it % 12, kc = it / 12;
        __syncthreads();
        if (tid < 256) { const int b = tid >> 6, k = tid & 63; sc[b][k] = siluf_(P.c[b * DM + kc * 64 + k]); }
        __syncthreads();
        const int n = nb * 512 + tid;
        float a0 = 0.f, a1 = 0.f, a2 = 0.f, a3 = 0.f;
#pragma unroll 8
        for (int k = 0; k < 64; ++k) { const float w = P.w_ada[(size_t)(kc * 64 + k) * NMOD + n]; a0 += sc[0][k] * w; a1 += sc[1][k] * w; a2 += sc[2][k] * w; a3 += sc[3][k] * w; }
        if (kc == 0) { const float bb = P.b_ada[n]; a0 += bb; a1 += bb; a2 += bb; a3 += bb; }
        atomicAdd(mod + 0 * NMOD + n, a0); atomicAdd(mod + 1 * NMOD + n, a1); atomicAdd(mod + 2 * NMOD + n, a2); atomicAdd(mod + 3 * NMOD + n, a3);
    }
}

__device__ __forceinline__ int rowmap(int n, int mode) { return mode == 0 ? n : ((n >> 7) * 256 + (mode == 2 ? 128 : 0) + (n & 127)); }
__device__ __forceinline__ void transpose_item(const float* W, int K, int N, bf16* WT, int mode, float* scr, int item, int lane) {
    const int nblk = N / 32, kb = item / nblk, nb = item % nblk, k0 = 64 * kb, n0 = 32 * nb;
#pragma unroll 8
    for (int i = 0; i < 32; ++i) { const int kk = 2 * i + (lane >> 5); scr[kk * 33 + (lane & 31)] = W[(size_t)(k0 + kk) * N + n0 + (lane & 31)]; }
    LDS_WAIT();
    const int c = lane & 7;
#pragma unroll
    for (int j = 0; j < 4; ++j) { const int n = (lane >> 3) + 8 * j; const float* s = scr + (8 * c) * 33 + n;
        u32x4 o; o.x = pk2(s[0 * 33], s[1 * 33]); o.y = pk2(s[2 * 33], s[3 * 33]); o.z = pk2(s[4 * 33], s[5 * 33]); o.w = pk2(s[6 * 33], s[7 * 33]);
        *(u32x4*)(WT + (size_t)rowmap(n0 + n, mode) * K + k0 + 8 * c) = o; }
    LDS_WAIT();
}
__device__ __forceinline__ void p_transposes(const Params& P, bf16* Win_t, bf16* Wout_t, bf16* Wgu_t, bf16* Wdn_t, bf16* WLT, bf16* ALT, bf16* GLT, float* lds, const int wv) {
    const int wave = wv, lane = lane_fresh();
    float* scr = lds + 1024 + wave * (64 * 33);
    constexpr int I_IN = (DM / 64) * (INC / 32), I_OUT = (DM / 64) * (DM / 32), I_G = (DM / 64) * (DFF / 32), I_DN = (DFF / 64) * (DM / 32);
    constexpr int I_L = (64 / 64) * (RW / 32), I_GL = (128 / 64) * (RW / 32);
    constexpr int NIT = I_OUT + I_DN + 2 * I_L + I_GL;
    for (int it = blockIdx.x * 8 + wave; it < NIT; it += gridDim.x * 8) {
        int r = it;
        if (r < I_OUT) { transpose_item(P.w_out, DM, DM, Wout_t, 0, scr, r, lane); continue; } r -= I_OUT;
        if (r < I_DN) { transpose_item(P.w_down, DFF, DM, Wdn_t, 0, scr, r, lane); continue; } r -= I_DN;
        if (r < I_L) { transpose_item(P.w_lora_up, 64, RW, WLT, 0, scr, r, lane); continue; } r -= I_L;
        if (r < I_L) { transpose_item(P.a_lora_up, 64, RW, ALT, 0, scr, r, lane); continue; } r -= I_L;
        transpose_item(P.g_lora_up, 128, RW, GLT, 0, scr, r, lane);
    }
}

__device__ __forceinline__ void p_modnorm(const float* src, const float* g, const float* mod, int shift_off, int scale_off, bf16* dst, const int wv) {
    const int wave = wv, lane = lane_fresh();
    for (int row = blockIdx.x * 8 + wave; row < NTOK; row += gridDim.x * 8) {
        const int b = row >> 13;
        const f32x4* xr = (const f32x4*)(src + (size_t)row * DM) + lane;
        f32x4 v[4]; float s = 0.f;
#pragma unroll
        for (int j = 0; j < 4; ++j) { v[j] = xr[64 * j]; s += (v[j].x * v[j].x + v[j].y * v[j].y) + (v[j].z * v[j].z + v[j].w * v[j].w); }
        const float rstd = 1.0f / sqrtf(wave_sum(s) * (1.f / DM) + NORM_EPS);
        unsigned long long* o8 = (unsigned long long*)(dst + (size_t)row * DM) + lane;
#pragma unroll
        for (int j = 0; j < 4; ++j) {
            const int col = 4 * lane + 256 * j;
            const f32x4 gg = *(const f32x4*)(g + col), sc = *(const f32x4*)(mod + b * NMOD + scale_off + col), sh = *(const f32x4*)(mod + b * NMOD + shift_off + col);
            const f32x4 o = v[j] * rstd * gg * (sc + 1.0f) + sh;
            o8[64 * j] = (unsigned long long)pk2(o.x, o.y) | ((unsigned long long)pk2(o.z, o.w) << 32);
        }
    }
}


__device__ __forceinline__ void fold_item(const float* W, int N, int NT, const float* g, const float* mod, int shift_off, int scale_off, bf16* WT, float* cvec, int mode, float* scr, int item, int lane) {
    constexpr int K = DM;
    const int nblk = N / 32, kb = item / nblk, nb = item % nblk, k0 = 64 * kb, n0 = 32 * nb;
#pragma unroll 8
    for (int i = 0; i < 32; ++i) { const int kk = 2 * i + (lane >> 5); scr[kk * 33 + (lane & 31)] = W[(size_t)(k0 + kk) * N + n0 + (lane & 31)]; }
    LDS_WAIT();
    const int c = lane & 7;
#pragma unroll 1
    for (int b = 0; b < 4; ++b) {
        const float* sc = mod + b * NMOD + scale_off + k0 + 8 * c;
        float G[8];
#pragma unroll
        for (int q = 0; q < 8; ++q) G[q] = g[k0 + 8 * c + q] * (1.0f + sc[q]);
#pragma unroll
        for (int j = 0; j < 4; ++j) { const int n = (lane >> 3) + 8 * j; const float* s = scr + (8 * c) * 33 + n;
            u32x4 o; o.x = pk2(s[0 * 33] * G[0], s[1 * 33] * G[1]); o.y = pk2(s[2 * 33] * G[2], s[3 * 33] * G[3]); o.z = pk2(s[4 * 33] * G[4], s[5 * 33] * G[5]); o.w = pk2(s[6 * 33] * G[6], s[7 * 33] * G[7]);
            *(u32x4*)(WT + (size_t)b * NT * K + (size_t)rowmap(n0 + n, mode) * K + k0 + 8 * c) = o; }
        const float* sh = mod + b * NMOD + shift_off + k0 + (lane >> 5) * 32;
        float a = 0.f;
#pragma unroll 8
        for (int q = 0; q < 32; ++q) a += sh[q] * scr[((lane >> 5) * 32 + q) * 33 + (lane & 31)];
        a += __shfl_xor(a, 32);
        if (lane < 32) atomicAdd(cvec + (size_t)b * NT + rowmap(n0 + lane, mode), a);
    }
    LDS_WAIT();
}
__device__ __forceinline__ void p_fold(const float* w_in, const float* w_gate, const float* w_up, const float* g1, const float* g2, const float* mod, bf16* Win_b, float* c1, bf16* Wgu_b, float* cgu, float* lds, const int wv) {
    const int wave = wv, lane = lane_fresh();
    float* scr = lds + 1024 + wave * (64 * 33);
    constexpr int I_G = (DM / 64) * (DFF / 32), I_IN = (DM / 64) * (INC / 32);
    for (int it = blockIdx.x * 8 + wave; it < 2 * I_G + I_IN; it += gridDim.x * 8) {
        if (it < I_G) fold_item(w_gate, DFF, 2 * DFF, g2, mod, 3 * DM, 4 * DM, Wgu_b, cgu, 1, scr, it, lane);
        else if (it < 2 * I_G) fold_item(w_up, DFF, 2 * DFF, g2, mod, 3 * DM, 4 * DM, Wgu_b, cgu, 2, scr, it - I_G, lane);
        else fold_item(w_in, INC, INC, g1, mod, 0, DM, Win_b, c1, 0, scr, it - 2 * I_G, lane);
    }
}
__device__ __forceinline__ void p_xb(const float* x, bf16* xb, float* rstd1, const int wv) {
    const int wave = wv, lane = lane_fresh();
    for (int row = blockIdx.x * 8 + wave; row < NTOK; row += gridDim.x * 8) {
        const f32x4* xr = (const f32x4*)(x + (size_t)row * DM) + lane;
        f32x4 v[4]; float s = 0.f;
#pragma unroll
        for (int j = 0; j < 4; ++j) { v[j] = __builtin_nontemporal_load(xr + 64 * j); s += (v[j].x * v[j].x + v[j].y * v[j].y) + (v[j].z * v[j].z + v[j].w * v[j].w); }
        s = wave_sum(s);
        if (lane == 0) rstd1[row] = 1.0f / sqrtf(s * (1.f / DM) + NORM_EPS);
        unsigned long long* o8 = (unsigned long long*)(xb + (size_t)row * DM) + lane;
#pragma unroll
        for (int j = 0; j < 4; ++j) o8[64 * j] = (unsigned long long)pk2(v[j].x, v[j].y) | ((unsigned long long)pk2(v[j].z, v[j].w) << 32);
    }
}

typedef short bf16x8 __attribute__((ext_vector_type(8)));
constexpr int LDA_ = 72;
constexpr int ARR = 64 * LDA_ * 2;
constexpr int O_NAT_A = 0, O_NAT_R = ARR, O_NAT_B = 2 * ARR, O_NAT_K = 3 * ARR, O_TR_A = 4 * ARR, O_TR_BH = 5 * ARR, O_TR_KH = 6 * ARR, O_TR_V = 7 * ARR;
constexpr int AABF_LD = 68;
constexpr int O_AABF = 8 * ARR, O_WT = O_AABF;
constexpr int O_AAK = O_AABF + 64 * AABF_LD * 4, O_U0T = O_NAT_K;
constexpr int O_ARB = O_AAK + ARR, O_ARK = O_ARB + ARR, O_TM = O_ARK + ARR, O_PT = O_TM + ARR;
constexpr int O_WSUM = O_PT + ARR, O_EGC = O_WSUM + 2048, O_RN = O_EGC + 256, O_PARX = O_RN + 256  , O_PAR = O_PARX + 512  , O_CHUNK_END = O_PAR + 8 * 2048;
static_assert(O_CHUNK_END <= 163840 - 1024, "chunk LDS map");

__device__ __forceinline__ f32x4 mm_tile(const LAS unsigned char* X, const LAS unsigned char* Y, int xa, int yb, int fr, int fq, f32x4 acc) {
#pragma unroll
    for (int ks = 0; ks < 2; ++ks) {
        const bf16x8 xf = *(const LAS bf16x8*)(X + ((xa + fr) * LDA_ + ks * 32 + fq * 8) * 2);
        const bf16x8 yf = *(const LAS bf16x8*)(Y + ((yb + fr) * LDA_ + ks * 32 + fq * 8) * 2);
        acc = __builtin_amdgcn_mfma_f32_16x16x32_bf16(xf, yf, acc, 0, 0, 0);
    }
    return acc;
}
__device__ __forceinline__ void st_tile_bf16(LAS unsigned char* Z, int xa, int yb, int fr, int fq, f32x4 acc) {
    u32x2 w; w.x = pk2(acc[0], acc[1]); w.y = pk2(acc[2], acc[3]);
    *(LAS u32x2*)(Z + ((yb + fr) * LDA_ + xa + 4 * fq) * 2) = w;
}
__device__ __forceinline__ float fexp(float x) { return __builtin_amdgcn_exp2f(x * 1.4426950408889634f); }
__device__ __forceinline__ float fsigmoid(float x) { return __builtin_amdgcn_rcpf(1.0f + fexp(-x)); }
__device__ __forceinline__ float ftanh(float x) { return 1.0f - 2.0f * __builtin_amdgcn_rcpf(1.0f + fexp(2.0f * x)); }
__device__ __forceinline__ float fsoftplus(float x) { return fmaxf(x, 0.f) + 0.6931471805599453f * __builtin_amdgcn_logf(1.0f + fexp(-fabsf(x))); }
template <int CTRL> __device__ __forceinline__ float dpp_mov(float v) { return __builtin_bit_cast(float, __builtin_amdgcn_update_dpp(0, __builtin_bit_cast(int, v), CTRL, 0xf, 0xf, true)); }
__device__ __forceinline__ float sum8(float v) { v += dpp_mov<0xB1>(v); v += dpp_mov<0x4E>(v); v += dpp_mov<0x141>(v); return v; }
__device__ __forceinline__ float bflo(unsigned u) { return __builtin_bit_cast(float, u << 16); }
__device__ __forceinline__ float bfhi(unsigned u) { return __builtin_bit_cast(float, u & 0xffff0000u); }
struct ChunkBufs { unsigned char *DG, *YI, *MQ, *H0; float* BON; const bf16 *WLT, *ALT, *GLT, *PRE; };

__device__ __forceinline__ void p_pre(const Params& P, const bf16* proj, bf16* PRE, const int wv) {
    const int lane = lane_fresh(), c0 = (lane & 31) * 8;
    const f32x4 m0 = *(const f32x4*)(P.rwkv_mu + 1536 + c0), m1 = *(const f32x4*)(P.rwkv_mu + 1536 + c0 + 4);
    for (int rp = blockIdx.x * 8 + wv; rp < NTOK / 2; rp += gridDim.x * 8) {
        const int row = rp * 2 + (lane >> 5);
        const bool first = (row & (SEQ - 1)) == 0;
        const u32x4 cu = *(const u32x4*)(proj + (size_t)row * INC + 1536 + c0);
        const u32x4 prv = *(const u32x4*)(proj + (size_t)(first ? row : row - 1) * INC + 1536 + c0);
        float v[8];
#pragma unroll
        for (int e = 0; e < 4; ++e) { const float c_lo = bflo(cu[e]), c_hi = bfhi(cu[e]), p_lo = first ? 0.f : bflo(prv[e]), p_hi = first ? 0.f : bfhi(prv[e]);
            const float mlo = (e < 2) ? m0[2 * e] : m1[2 * e - 4], mhi = (e < 2) ? m0[2 * e + 1] : m1[2 * e - 3];
            v[2 * e] = c_lo + (p_lo - c_lo) * mlo; v[2 * e + 1] = c_hi + (p_hi - c_hi) * mhi; }
        if (c0 < 64) {
#pragma unroll
            for (int e = 0; e < 8; ++e) v[e] = ftanh(v[e]); }
        else if (c0 >= 128) {
#pragma unroll
            for (int e = 0; e < 8; ++e) v[e] = fsigmoid(v[e]); }
        u32x4 o; o.x = pk2(v[0], v[1]); o.y = pk2(v[2], v[3]); o.z = pk2(v[4], v[5]); o.w = pk2(v[6], v[7]);
        *(u32x4*)(PRE + (size_t)row * 256 + c0) = o;
    }
}
struct RawLd { u32x4 xw, xa, k_c, k_p, r_c, r_p, v_c, v_p; bf16x8 wf0, wf1; };
__device__ __forceinline__ void chunk_issue(RawLd& R, const bf16* proj, const ChunkBufs& CB, int unit, int tid) {
    const int ch = unit & 127, h = (unit >> 7) & 7, b = unit >> 10, t = tid >> 3, kc = (tid & 7) * 8;
    const size_t row = (size_t)b * SEQ + ch * 64 + t, prow = (ch == 0 && t == 0) ? row : row - 1;
    const bf16* pc = proj + row * INC; const bf16* pp = proj + prow * INC;
    R.xw = *(const u32x4*)(CB.PRE + row * 256 + kc); R.xa = *(const u32x4*)(CB.PRE + row * 256 + 64 + kc);
    R.k_c = *(const u32x4*)(pc + 512 + h * 64 + kc); R.k_p = *(const u32x4*)(pp + 512 + h * 64 + kc);
    R.r_c = *(const u32x4*)(pc + h * 64 + kc); R.r_p = *(const u32x4*)(pp + h * 64 + kc); R.v_c = *(const u32x4*)(pc + 1024 + h * 64 + kc); R.v_p = *(const u32x4*)(pp + 1024 + h * 64 + kc);
    { const int wave = tid >> 6, lane = tid & 63; const bf16* Wt = ((wave >> 2) ? CB.ALT : CB.WLT) + (size_t)(h * 64 + (wave & 3) * 16 + (lane & 15)) * 64 + (lane >> 4) * 8; R.wf0 = *(const bf16x8*)(Wt); R.wf1 = *(const bf16x8*)(Wt + 32); }
}
__device__ __forceinline__ void p_chunkA(const Params& P, const bf16* proj, const ChunkBufs& CB, unsigned char* lds_, const int wv) {
    LAS unsigned char* L = (LAS unsigned char*)lds_;
    const int tid_ = wv * 64 + lane_fresh();
    const int tid = tid_, wave = wv, lane = tid & 63, fr = lane & 15, fq = lane >> 4;
    LAS float* wsum = (LAS float*)(L + O_WSUM);
    LAS float* egc = (LAS float*)(L + O_EGC);
    constexpr int O_XW = O_ARK, O_XA = O_TM, O_ZW = O_AABF, O_ZA = O_AAK, ZLD = 68, O_PB = O_ARK;
    constexpr int O_AABH = O_PT, O_TMT = O_NAT_A, O_ZT1 = O_NAT_B, O_ZT2 = O_NAT_K;
    constexpr int RLD = 72, O_RAWR = O_NAT_A, O_RAWK = O_RAWR + 65 * RLD * 2, O_RAWV = O_RAWK + 65 * RLD * 2;
    static_assert(O_RAWV + 65 * RLD * 2 <= O_TR_A, "raw staging fits the natural arrays");
    RawLd cur, nxt;
    {
        LAS float* par = (LAS float*)(L + O_PAR); const int c = tid_;
        par[0 * 512 + c] = P.rwkv_mu[c]; par[1 * 512 + c] = P.rwkv_mu[512 + c]; par[2 * 512 + c] = P.rwkv_mu[1024 + c]; par[3 * 512 + c] = P.r_k[c];
        par[4 * 512 + c] = P.w0[c]; par[5 * 512 + c] = P.a0[c]; par[6 * 512 + c] = P.k_k[c]; par[7 * 512 + c] = P.k_a[c];
    }
    if ((int)blockIdx.x < BATCH * 8 * 128) chunk_issue(cur, proj, CB, blockIdx.x, tid);
    for (int unit = blockIdx.x; unit < BATCH * 8 * 128; unit += gridDim.x) {
        const int ch = unit & 127, h = (unit >> 7) & 7, b = unit >> 10;
        const size_t rowbase = (size_t)b * SEQ + ch * 64;
        const int tidl_ = wv * 64 + lane_fresh();
        const int tid = tidl_, lane = tid & 63, fr = lane & 15, fq = lane >> 4;
        unsigned char* const uDG = CB.DG + (size_t)unit * 8192; unsigned char* const uYI = CB.YI + (size_t)unit * 8192; unsigned char* const uMQ = CB.MQ + (size_t)unit * 16384;
        __syncthreads();
        {
            const int t = tid >> 3, kc = (tid & 7) * 8;
            const bool first = (ch == 0 && t == 0);
            const u32x4 zero4 = (u32x4){0u, 0u, 0u, 0u};
            const u32x4 k_p = first ? zero4 : cur.k_p, r_p = first ? zero4 : cur.r_p, v_p = first ? zero4 : cur.v_p;
            *(LAS u32x4*)(L + O_XW + (t * LDA_ + kc) * 2) = cur.xw; *(LAS u32x4*)(L + O_XA + (t * LDA_ + kc) * 2) = cur.xa;
            {
                const int c0 = 512 + h * 64 + kc;
                const f32x4 m0 = *(const LAS f32x4*)(L + O_PAR + (1 * 512 + h * 64 + kc) * 4), m1 = *(const LAS f32x4*)(L + O_PAR + (1 * 512 + h * 64 + kc + 4) * 4), q0 = *(const LAS f32x4*)(L + O_PAR + (6 * 512 + h * 64 + kc) * 4), q1 = *(const LAS f32x4*)(L + O_PAR + (6 * 512 + h * 64 + kc + 4) * 4);
                float ss = 0.f;
#pragma unroll
                for (int e = 0; e < 4; ++e) { const float c_lo = bflo(cur.k_c[e]), c_hi = bfhi(cur.k_c[e]), p_lo = bflo(k_p[e]), p_hi = bfhi(k_p[e]);
                    const float mlo = (e < 2) ? m0[2 * e] : m1[2 * e - 4], mhi = (e < 2) ? m0[2 * e + 1] : m1[2 * e - 3], klo = (e < 2) ? q0[2 * e] : q1[2 * e - 4], khi = (e < 2) ? q0[2 * e + 1] : q1[2 * e - 3];
                    const float a = (c_lo + (p_lo - c_lo) * mlo) * klo, bq = (c_hi + (p_hi - c_hi) * mhi) * khi; ss += a * a + bq * bq; }
                ss = sum8(ss);
                if ((tid & 7) == 0) *(LAS float*)(L + O_RN + t * 4) = 1.0f / fmaxf(sqrtf(ss), 1e-12f);
            }
            *(LAS u32x4*)(L + O_RAWR + ((t + 1) * RLD + kc) * 2) = cur.r_c; *(LAS u32x4*)(L + O_RAWK + ((t + 1) * RLD + kc) * 2) = cur.k_c; *(LAS u32x4*)(L + O_RAWV + ((t + 1) * RLD + kc) * 2) = cur.v_c;
            if (t == 0) { *(LAS u32x4*)(L + O_RAWR + kc * 2) = r_p; *(LAS u32x4*)(L + O_RAWK + kc * 2) = k_p; *(LAS u32x4*)(L + O_RAWV + kc * 2) = v_p; }
        }
        const int j = lane, tg = wave, col = h * 64 + j;
        const size_t row0 = rowbase + tg * 8;
        __syncthreads();
        {
            const int which = wave >> 2, ct = wave & 3;
            const bf16x8 wf0 = cur.wf0, wf1 = cur.wf1;
            const LAS unsigned char* X = L + (which ? O_XA : O_XW);
#pragma unroll
            for (int tt = 0; tt < 4; ++tt) {
                f32x4 acc = (f32x4){0.f, 0.f, 0.f, 0.f};
                const bf16x8 x0 = *(const LAS bf16x8*)(X + ((tt * 16 + fr) * LDA_ + fq * 8) * 2), x1 = *(const LAS bf16x8*)(X + ((tt * 16 + fr) * LDA_ + 32 + fq * 8) * 2);
                acc = __builtin_amdgcn_mfma_f32_16x16x32_bf16(x0, wf0, acc, 0, 0, 0);
                acc = __builtin_amdgcn_mfma_f32_16x16x32_bf16(x1, wf1, acc, 0, 0, 0);
                *(LAS f32x4*)(L + (which ? O_ZA : O_ZW) + ((ct * 16 + fr) * ZLD + tt * 16 + 4 * fq) * 4) = acc;
            }
        }
        __syncthreads();
        if (unit + (int)gridDim.x < BATCH * 8 * 128) chunk_issue(nxt, proj, CB, unit + gridDim.x, tid);
        {
            float lw[8], kp[8], kk[8], bb[8], r[8], v[8];
            float pr_[9], pk_[9], pv_[9];
#pragma unroll
            for (int q = 0; q < 9; ++q) { pr_[q] = bf2f(*(const LAS unsigned short*)(L + O_RAWR + ((tg * 8 + q) * RLD + j) * 2)); pk_[q] = bf2f(*(const LAS unsigned short*)(L + O_RAWK + ((tg * 8 + q) * RLD + j) * 2)); pv_[q] = bf2f(*(const LAS unsigned short*)(L + O_RAWV + ((tg * 8 + q) * RLD + j) * 2)); }
            const LAS float* par = (const LAS float*)(L + O_PAR) + col;
            const float mur = par[0], muk = par[512], muv = par[1024], rk = par[1536], w0 = par[2048], a0 = par[2560], kkc = par[3072], kac = par[3584];
            const float nw0 = -1.4426950408889634f * w0, na0 = -1.4426950408889634f * a0, kc1 = 1.0f - kac;
            const f32x4 rn0 = *(const LAS f32x4*)(L + O_RN + (tg * 8) * 4), rn1 = *(const LAS f32x4*)(L + O_RN + (tg * 8 + 4) * 4);
            const f32x4 zw0 = *(const LAS f32x4*)(L + O_ZW + (j * ZLD + tg * 8) * 4), zw1 = *(const LAS f32x4*)(L + O_ZW + (j * ZLD + tg * 8 + 4) * 4);
            const f32x4 za0 = *(const LAS f32x4*)(L + O_ZA + (j * ZLD + tg * 8) * 4), za1 = *(const LAS f32x4*)(L + O_ZA + (j * ZLD + tg * 8 + 4) * 4);
#pragma unroll
            for (int tt = 0; tt < 8; ++tt) {
                const float zw = (tt < 4) ? zw0[tt & 3] : zw1[tt & 3], za = (tt < 4) ? za0[tt & 3] : za1[tt & 3];
                r[tt] = pr_[tt + 1] + (pr_[tt] - pr_[tt + 1]) * mur; v[tt] = pv_[tt + 1] + (pv_[tt] - pv_[tt + 1]) * muv;
                const float k = pk_[tt + 1] + (pk_[tt] - pk_[tt + 1]) * muk;
                lw[tt] = -0.8750387749145276f * __builtin_amdgcn_rcpf(1.0f + __builtin_amdgcn_exp2f(__builtin_fmaf(zw, -1.4426950408889634f, nw0)));
                const float a = __builtin_amdgcn_rcpf(1.0f + __builtin_amdgcn_exp2f(__builtin_fmaf(za, -1.4426950408889634f, na0)));
                kk[tt] = k * kkc * ((tt < 4) ? rn0[tt & 3] : rn1[tt & 3]);
                kp[tt] = k * __builtin_fmaf(a, kac, kc1);
                bb[tt] = kk[tt] * a;
                *(LAS float*)(L + O_PB + ((tg * 8 + tt) * ZLD + j) * 4) = r[tt] * kp[tt] * rk;
            }
            float gl[8]; float s = 0.f;
#pragma unroll
            for (int tt = 0; tt < 8; ++tt) { s += lw[tt]; gl[tt] = s; }
            wsum[tg * 64 + j] = s;
            __syncthreads();
            { const int t = tid >> 3, kc = (tid & 7) * 8;
              const f32x4 b0 = *(const LAS f32x4*)(L + O_PB + (t * ZLD + kc) * 4), b1 = *(const LAS f32x4*)(L + O_PB + (t * ZLD + kc + 4) * 4);
              const float bs = sum8(((b0[0] + b0[1]) + (b0[2] + b0[3])) + ((b1[0] + b1[1]) + (b1[2] + b1[3])));
              if ((tid & 7) == 0) CB.BON[(rowbase + t) * 8 + h] = bs; }
            float off = 0.f, tot = 0.f;
#pragma unroll
            for (int g = 0; g < 8; ++g) { const float ws = wsum[g * 64 + j]; tot += ws; if (g < tg) off += ws; }
            const float etot = __builtin_amdgcn_exp2f(tot);
            if (tg == 0) egc[j] = etot;
            u32x4 tA, tBH, tKH, tV;
            float e_prev = __builtin_amdgcn_exp2f(off);
#pragma unroll
            for (int tp = 0; tp < 4; ++tp) {
                float At[2], Rt[2], Bt[2], Kt[2], Bh[2], Kh[2];
#pragma unroll
                for (int u = 0; u < 2; ++u) { const int tt = 2 * tp + u;
                    const float e_i = __builtin_amdgcn_exp2f(off + gl[tt]), e_n = __builtin_amdgcn_rcpf(e_i);
                    At[u] = -kk[tt] * e_prev; Rt[u] = r[tt] * e_i; Bt[u] = bb[tt] * e_n; Kt[u] = kp[tt] * e_n; Bh[u] = Bt[u] * etot; Kh[u] = Kt[u] * etot; e_prev = e_i; }
                const unsigned pa = pk2(At[0], At[1]), pr = pk2(Rt[0], Rt[1]), pb = pk2(Bt[0], Bt[1]), pk_ = pk2(Kt[0], Kt[1]);
                const int t0 = tg * 8 + 2 * tp;
                *(LAS unsigned short*)(L + O_NAT_A + (t0 * LDA_ + j) * 2) = (unsigned short)pa; *(LAS unsigned short*)(L + O_NAT_A + ((t0 + 1) * LDA_ + j) * 2) = (unsigned short)(pa >> 16);
                *(LAS unsigned short*)(L + O_NAT_R + (t0 * LDA_ + j) * 2) = (unsigned short)pr; *(LAS unsigned short*)(L + O_NAT_R + ((t0 + 1) * LDA_ + j) * 2) = (unsigned short)(pr >> 16);
                *(LAS unsigned short*)(L + O_NAT_B + (t0 * LDA_ + j) * 2) = (unsigned short)pb; *(LAS unsigned short*)(L + O_NAT_B + ((t0 + 1) * LDA_ + j) * 2) = (unsigned short)(pb >> 16);
                *(LAS unsigned short*)(L + O_NAT_K + (t0 * LDA_ + j) * 2) = (unsigned short)pk_; *(LAS unsigned short*)(L + O_NAT_K + ((t0 + 1) * LDA_ + j) * 2) = (unsigned short)(pk_ >> 16);
                tA[tp] = pa; tBH[tp] = pk2(Bh[0], Bh[1]); tKH[tp] = pk2(Kh[0], Kh[1]); tV[tp] = pk2(v[2 * tp], v[2 * tp + 1]);
            }
            *(LAS u32x4*)(L + O_TR_A + (j * LDA_ + tg * 8) * 2) = tA;
            *(LAS u32x4*)(L + O_TR_BH + (j * LDA_ + tg * 8) * 2) = tBH;
            *(LAS u32x4*)(L + O_TR_KH + (j * LDA_ + tg * 8) * 2) = tKH;
            *(LAS u32x4*)(L + O_TR_V + (j * LDA_ + tg * 8) * 2) = tV;
        }
        __syncthreads();
#define FRAG(arr, row, ks) (*(const LAS bf16x8*)(lbase + (unsigned)((arr) + (row) * (LDA_ * 2) + (ks) * 64)))
        unsigned lbase = (unsigned)(uintptr_t)L + (unsigned)((fr * LDA_ + fq * 8) * 2); asm volatile("" : "+v"(lbase));
#define MM2(x0, x1, y0, y1, c) __builtin_amdgcn_mfma_f32_16x16x32_bf16(x1, y1, __builtin_amdgcn_mfma_f32_16x16x32_bf16(x0, y0, c, 0, 0, 0), 0, 0, 0)
        const f32x4 zacc = (f32x4){0.f, 0.f, 0.f, 0.f};
        if (wave == 0) {
            {
                bf16x8 xb_[4][2], ya_[4][2];
#pragma unroll
                for (int I = 0; I < 4; ++I)
#pragma unroll
                    for (int ks = 0; ks < 2; ++ks) { xb_[I][ks] = FRAG(O_NAT_B, I * 16, ks); ya_[I][ks] = FRAG(O_NAT_A, I * 16, ks); }
#pragma unroll
                for (int I = 0; I < 4; ++I) { f32x4 d_ = MM2(xb_[I][0], xb_[I][1], ya_[I][0], ya_[I][1], zacc);
#pragma unroll
                    for (int r = 0; r < 4; ++r) d_[r] = (4 * fq + r < fr) ? d_[r] : 0.f;
                    *(LAS f32x4*)(L + O_AABF + ((I * 16 + fr) * AABF_LD + I * 16 + 4 * fq) * 4) = d_; }
            }
            LDS_WAIT();
            const int blk = lane >> 4, c = lane & 15;
            const LAS float* A = (const LAS float*)(L + O_AABF) + (16 * blk) * AABF_LD + 16 * blk;
            f32x4 ar[16][4];
#pragma unroll
            for (int r = 1; r < 16; ++r)
#pragma unroll
                for (int k = 0; k < 4; ++k) if (4 * k < r) ar[r][k] = *(const LAS f32x4*)(A + r * AABF_LD + 4 * k);
            float x[16];
            x[0] = (c == 0) ? 1.f : 0.f;
#pragma unroll
            for (int r = 1; r < 16; ++r) {
                float a0 = (r == c) ? 1.f : 0.f, a1 = 0.f;
#pragma unroll
                for (int q = 0; q < r; ++q) { if (q & 1) a1 += ar[r][q >> 2][q & 3] * x[q]; else a0 += ar[r][q >> 2][q & 3] * x[q]; }
                x[r] = a0 + a1;
            }
#pragma unroll
            for (int r = 0; r < 16; r += 2) { const unsigned pr = pk2(x[r], x[r + 1]);
                *(LAS unsigned short*)(L + O_TM + ((16 * blk + r) * LDA_ + 16 * blk + c) * 2) = (unsigned short)(pr & 0xffffu); *(LAS unsigned short*)(L + O_TM + ((16 * blk + r + 1) * LDA_ + 16 * blk + c) * 2) = (unsigned short)(pr >> 16); }
        } else if (wave != 4) {
            const int v_ = (wave < 4) ? wave - 1 : wave - 2, p = 1 + (v_ >> 1), o = v_ & 1;
            const int oX = (p & 1) ? O_NAT_K : O_NAT_B, oY = (p >> 1) ? O_NAT_R : O_NAT_A;
            const int tA = o, tB = 3 - o, s1 = o ? 1 : 3;
            bf16x8 xf[4][2], yf[2][2];
#pragma unroll
            for (int ks = 0; ks < 2; ++ks) { xf[0][ks] = FRAG(oX, 0, ks); xf[1][ks] = FRAG(oX, 16, ks); xf[2][ks] = FRAG(oX, 32, ks); xf[3][ks] = FRAG(oX, s1 * 16, ks); yf[0][ks] = FRAG(oY, tA * 16, ks); yf[1][ks] = FRAG(oY, tB * 16, ks); }
            f32x4 acc[5]; int tts[5], sts[5];
            acc[0] = MM2(xf[0][0], xf[0][1], yf[0][0], yf[0][1], zacc); tts[0] = tA; sts[0] = 0;
            acc[1] = o ? MM2(xf[3][0], xf[3][1], yf[0][0], yf[0][1], zacc) : MM2(xf[3][0], xf[3][1], yf[1][0], yf[1][1], zacc); tts[1] = o ? tA : tB; sts[1] = s1;
            acc[2] = MM2(xf[0][0], xf[0][1], yf[1][0], yf[1][1], zacc); tts[2] = tB; sts[2] = 0;
            acc[3] = MM2(xf[1][0], xf[1][1], yf[1][0], yf[1][1], zacc); tts[3] = tB; sts[3] = 1;
            acc[4] = MM2(xf[2][0], xf[2][1], yf[1][0], yf[1][1], zacc); tts[4] = tB; sts[4] = 2;
            const int oZ = (p == 1) ? O_AAK : ((p == 2) ? O_ARB : O_ARK);
#pragma unroll
            for (int k = 0; k < 5; ++k) {
                const int t = tts[k] * 16 + fr, s0 = sts[k] * 16 + 4 * fq;
#pragma unroll
                for (int r = 0; r < 4; ++r) { const bool keep = (p < 2) ? (s0 + r < t) : (s0 + r <= t); acc[k][r] = keep ? acc[k][r] : 0.f; }
                st_tile_bf16(L + oZ, sts[k] * 16, tts[k] * 16, fr, fq, acc[k]);
            }
            st_tile_bf16(L + oZ, (o ? 2 : 1) * 16, (o ? 1 : 0) * 16, fr, fq, zacc); st_tile_bf16(L + oZ, (o ? 3 : 2) * 16, (o ? 1 : 0) * 16, fr, fq, zacc); st_tile_bf16(L + oZ, 3 * 16, (o ? 2 : 0) * 16, fr, fq, zacc);
        } else {
            bf16x8 xf[3][2], yf[3][2];
#pragma unroll
            for (int ks = 0; ks < 2; ++ks)
#pragma unroll
                for (int q = 0; q < 3; ++q) { xf[q][ks] = FRAG(O_NAT_B, q * 16, ks); yf[q][ks] = FRAG(O_NAT_A, (q + 1) * 16, ks); }
            f32x4 acc[6];
            acc[0] = MM2(xf[0][0], xf[0][1], yf[0][0], yf[0][1], zacc);
            acc[1] = MM2(xf[0][0], xf[0][1], yf[1][0], yf[1][1], zacc); acc[2] = MM2(xf[1][0], xf[1][1], yf[1][0], yf[1][1], zacc);
            acc[3] = MM2(xf[0][0], xf[0][1], yf[2][0], yf[2][1], zacc); acc[4] = MM2(xf[1][0], xf[1][1], yf[2][0], yf[2][1], zacc); acc[5] = MM2(xf[2][0], xf[2][1], yf[2][0], yf[2][1], zacc);
            st_tile_bf16(L + O_AABH, 0, 16, fr, fq, acc[0]);
            st_tile_bf16(L + O_AABH, 0, 32, fr, fq, acc[1]); st_tile_bf16(L + O_AABH, 16, 32, fr, fq, acc[2]);
            st_tile_bf16(L + O_AABH, 0, 48, fr, fq, acc[3]); st_tile_bf16(L + O_AABH, 16, 48, fr, fq, acc[4]); st_tile_bf16(L + O_AABH, 32, 48, fr, fq, acc[5]);
        }
        __syncthreads();
        asm volatile("" : "+v"(lbase));
        {
            const int isU = wave >> 2, ct = wave & 3;
            const int oXo = isU ? O_U0T : O_WT;
            u32x2 tii[4], ab[6]; f32x4 R_[4];
#pragma unroll
            for (int I = 0; I < 4; ++I) tii[I] = *(const LAS u32x2*)(L + O_TM + ((16 * I + fr) * LDA_ + 16 * I + 4 * fq) * 2);
            if (isU) {
                bf16x8 vf[2], af[4][2];
#pragma unroll
                for (int ks = 0; ks < 2; ++ks) { vf[ks] = FRAG(O_TR_V, ct * 16, ks);
#pragma unroll
                    for (int I = 0; I < 4; ++I) af[I][ks] = FRAG(O_AAK, I * 16, ks); }
#pragma unroll
                for (int I = 0; I < 4; ++I) R_[I] = MM2(af[I][0], af[I][1], vf[0], vf[1], zacc);
            } else {
#pragma unroll
                for (int I = 0; I < 4; ++I) { const u32x2 q_ = *(const LAS u32x2*)(L + O_TR_A + ((16 * ct + fr) * LDA_ + 16 * I + 4 * fq) * 2); R_[I] = (f32x4){bflo(q_.x), bfhi(q_.x), bflo(q_.y), bfhi(q_.y)}; }
            }
#define AB_(I, J) (*(const LAS u32x2*)(L + O_AABH + ((16 * (I) + fr) * LDA_ + 16 * (J) + 4 * fq) * 2))
            ab[0] = AB_(1, 0); ab[1] = AB_(2, 0); ab[2] = AB_(2, 1); ab[3] = AB_(3, 0); ab[4] = AB_(3, 1); ab[5] = AB_(3, 2);
#undef AB_
            const u32x2 z2 = (u32x2){0u, 0u};
#define MK8(lo, hi) __builtin_bit_cast(bf16x8, (u32x4){(lo).x, (lo).y, (hi).x, (hi).y})
#define UNP(q) (f32x4){bflo((q).x), bfhi((q).x), bflo((q).y), bfhi((q).y)}
#define PKA(a_) (u32x2){pk2((a_)[0], (a_)[1]), pk2((a_)[2], (a_)[3])}
            f32x4 X0, X1, X2, X3, a_;
            a_ = R_[0];
            { const u32x2 p = PKA(a_); X0 = __builtin_amdgcn_mfma_f32_16x16x32_bf16(MK8(tii[0], z2), MK8(p, z2), zacc, 0, 0, 0); }
            const u32x2 x0p = PKA(X0);
            a_ = __builtin_amdgcn_mfma_f32_16x16x32_bf16(MK8(ab[0], z2), MK8(x0p, z2), R_[1], 0, 0, 0);
            { const u32x2 p = PKA(a_); X1 = __builtin_amdgcn_mfma_f32_16x16x32_bf16(MK8(tii[1], z2), MK8(p, z2), zacc, 0, 0, 0); }
            const u32x2 x1p = PKA(X1);
            a_ = __builtin_amdgcn_mfma_f32_16x16x32_bf16(MK8(ab[1], ab[2]), MK8(x0p, x1p), R_[2], 0, 0, 0);
            { const u32x2 p = PKA(a_); X2 = __builtin_amdgcn_mfma_f32_16x16x32_bf16(MK8(tii[2], z2), MK8(p, z2), zacc, 0, 0, 0); }
            const u32x2 x2p = PKA(X2);
            a_ = __builtin_amdgcn_mfma_f32_16x16x32_bf16(MK8(ab[3], ab[4]), MK8(x0p, x1p), R_[3], 0, 0, 0);
            a_ = __builtin_amdgcn_mfma_f32_16x16x32_bf16(MK8(ab[5], z2), MK8(x2p, z2), a_, 0, 0, 0);
            { const u32x2 p = PKA(a_); X3 = __builtin_amdgcn_mfma_f32_16x16x32_bf16(MK8(tii[3], z2), MK8(p, z2), zacc, 0, 0, 0); }
#undef MK8
#undef UNP
#undef PKA
            st_tile_bf16(L + oXo, 0, 16 * ct, fr, fq, X0); st_tile_bf16(L + oXo, 16, 16 * ct, fr, fq, X1); st_tile_bf16(L + oXo, 32, 16 * ct, fr, fq, X2); st_tile_bf16(L + oXo, 48, 16 * ct, fr, fq, X3);
        }
        __syncthreads();
        asm volatile("" : "+v"(lbase));
        {
            const int xt = wave & 3, y0 = wave >> 2;
            bf16x8 wtf[2], bhf[2][2], arf[2][2];
#pragma unroll
            for (int ks = 0; ks < 2; ++ks) { wtf[ks] = FRAG(O_WT, xt * 16, ks);
#pragma unroll
                for (int q = 0; q < 2; ++q) { bhf[q][ks] = FRAG(O_TR_BH, (y0 + 2 * q) * 16, ks); arf[q][ks] = FRAG(O_ARB, (y0 + 2 * q) * 16, ks); } }
            u32x2 rr[2];
#pragma unroll
            for (int q = 0; q < 2; ++q) rr[q] = *(const LAS u32x2*)(L + O_NAT_R + (((y0 + 2 * q) * 16 + fr) * LDA_ + xt * 16 + 4 * fq) * 2);
            float eg[2];
#pragma unroll
            for (int q = 0; q < 2; ++q) eg[q] = egc[(y0 + 2 * q) * 16 + fr];
            f32x4 am[2], aq[2];
#pragma unroll
            for (int q = 0; q < 2; ++q) { am[q] = MM2(wtf[0], wtf[1], bhf[q][0], bhf[q][1], zacc); aq[q] = MM2(wtf[0], wtf[1], arf[q][0], arf[q][1], zacc); }
#pragma unroll
            for (int q = 0; q < 2; ++q) {
                const int yt = y0 + 2 * q, yi = yt * 16 + fr, k0 = xt * 16 + 4 * fq, pos = (32 * (xt >> 1) + 8 * fq + 4 * (xt & 1)) * 2;
#pragma unroll
                for (int r = 0; r < 4; ++r) if (k0 + r == yi) am[q][r] += eg[q];
                u32x2 w; w.x = pk2(am[q][0], am[q][1]); w.y = pk2(am[q][2], am[q][3]);
                *(u32x2*)(uMQ + yi * 128 + pos) = w;
                aq[q][0] += bflo(rr[q].x); aq[q][1] += bfhi(rr[q].x); aq[q][2] += bflo(rr[q].y); aq[q][3] += bfhi(rr[q].y);
                u32x2 v; v.x = pk2(aq[q][0], aq[q][1]); v.y = pk2(aq[q][2], aq[q][3]);
                *(u32x2*)(uMQ + 8192 + yi * 128 + pos) = v;
            }
        }
        asm volatile("" : "+v"(lbase));
        {
            const int xt = wave & 3, y0 = wave >> 2;
            bf16x8 bhx[2], khx[2], u0x[2], vx[2], u0y[2][2], vy[2][2], ary[2][2], aky[2][2];
#pragma unroll
            for (int ks = 0; ks < 2; ++ks) { bhx[ks] = FRAG(O_TR_BH, xt * 16, ks); khx[ks] = FRAG(O_TR_KH, xt * 16, ks); u0x[ks] = FRAG(O_U0T, xt * 16, ks); vx[ks] = FRAG(O_TR_V, xt * 16, ks);
#pragma unroll
                for (int q = 0; q < 2; ++q) { u0y[q][ks] = FRAG(O_U0T, (y0 + 2 * q) * 16, ks); vy[q][ks] = FRAG(O_TR_V, (y0 + 2 * q) * 16, ks); ary[q][ks] = FRAG(O_ARB, (y0 + 2 * q) * 16, ks); aky[q][ks] = FRAG(O_ARK, (y0 + 2 * q) * 16, ks); } }
            f32x4 ad[2], ay[2];
#pragma unroll
            for (int q = 0; q < 2; ++q) { ad[q] = MM2(khx[0], khx[1], vy[q][0], vy[q][1], MM2(bhx[0], bhx[1], u0y[q][0], u0y[q][1], zacc)); ay[q] = MM2(vx[0], vx[1], aky[q][0], aky[q][1], MM2(u0x[0], u0x[1], ary[q][0], ary[q][1], zacc)); }
#pragma unroll
            for (int q = 0; q < 2; ++q) { const int yt = y0 + 2 * q;
                u32x2 wd; wd.x = pk2(ad[q][0], ad[q][1]); wd.y = pk2(ad[q][2], ad[q][3]); *(u32x2*)(uDG + (yt * 4 + xt) * 512 + lane * 8) = wd;
                u32x2 wy; wy.x = pk2(ay[q][0], ay[q][1]); wy.y = pk2(ay[q][2], ay[q][3]); *(u32x2*)(uYI + (yt * 4 + xt) * 512 + lane * 8) = wy; }
        }
#undef FRAG
#undef MM2
        cur = nxt;
    }
}

constexpr int SB_NL = 2, SB_Q = 6, SB_DEPTH = 14, SB_SLOT = 10240, SB_FLAGS = SB_DEPTH * SB_SLOT;
static_assert((SB_Q - 1) * SB_NL < SB_DEPTH && SB_Q * 10 <= 63 && SB_DEPTH % SB_NL == 0 && SB_FLAGS + 128 <= 163840, "ring geometry");
__device__ __forceinline__ void glds16(const void* gsrc, unsigned lds_dst) { unsigned keep;
    asm volatile("s_mov_b32 %0, m0\n\ts_mov_b32 m0, %2\n\ts_nop 0\n\tglobal_load_lds_dwordx4 %1, off\n\ts_mov_b32 m0, %0" : "=&s"(keep) : "v"(gsrc), "s"(lds_dst) : "memory"); }
__device__ __forceinline__ void sb_issue(const unsigned char* uMQ, const unsigned char* uDG, int it, int lane, unsigned slot_addr) {
    const int fr = lane & 15, fq = lane >> 4;
#pragma unroll
    for (int jt = 0; jt < 4; ++jt)
#pragma unroll
        for (int ks = 0; ks < 2; ++ks)
            glds16(uMQ + (jt * 16 + fr) * 128 + (32 * ks + 8 * fq) * 2, (unsigned)__builtin_amdgcn_readfirstlane((int)(slot_addr + (jt * 2 + ks) * 1024)));
#pragma unroll
    for (int p = 0; p < 2; ++p)
        glds16(uDG + it * 2048 + p * 1024 + lane * 16, (unsigned)__builtin_amdgcn_readfirstlane((int)(slot_addr + 8192 + p * 1024)));
}
__device__ __forceinline__ unsigned lds_poll(const LAS unsigned* p) { return (unsigned)__builtin_amdgcn_readfirstlane((int)*(const volatile LAS unsigned*)p); }
template <int N> __device__ __forceinline__ void wait_vm() { asm volatile("s_waitcnt vmcnt(%0)" :: "n"(N) : "memory"); }
__device__ __forceinline__ void p_chunkB(const ChunkBufs& CB, unsigned char* lds_, const int wv) {
    LAS unsigned char* L = (LAS unsigned char*)lds_;
    LAS unsigned* flg = (LAS unsigned*)(L + SB_FLAGS);
    for (int item = blockIdx.x; item < 128; item += gridDim.x) {
    __syncthreads();
    if (wv == 0) { const int l0 = lane_fresh(); if (l0 < 32) flg[l0] = 0u; }
    __syncthreads();
    if (wv > SB_NL) continue;
    const int lane = lane_fresh();
    const int pr = (item & 7) + 8 * ((item >> 5) & 3), it = (item >> 3) & 3, h = pr & 7, b = pr >> 3;
    const unsigned lds0 = (unsigned)(uintptr_t)L;
    const size_t u0 = (size_t)(b * 8 + h) * 128;
    if (wv == 0) {
        f32x4 acc[4];
#pragma unroll
        for (int jt = 0; jt < 4; ++jt) acc[jt] = (f32x4){0.f, 0.f, 0.f, 0.f};
        u32x4 mfA[4][2], mfB[4][2]; u32x2 dA[4], dB[4];
#define SB_READ(MF, D, SL) { const LAS unsigned char* S_ = L + (SL) * SB_SLOT; _Pragma("unroll") for (int jt = 0; jt < 4; ++jt) { MF[jt][0] = *(const LAS u32x4*)(S_ + (jt * 2 + 0) * 1024 + lane * 16); MF[jt][1] = *(const LAS u32x4*)(S_ + (jt * 2 + 1) * 1024 + lane * 16); D[jt] = *(const LAS u32x2*)(S_ + 8192 + jt * 512 + lane * 8); } }
        while (lds_poll(flg) != 1u) { }
        asm volatile("" ::: "memory");
        SB_READ(mfA, dA, 0);
        unsigned f = *(const volatile LAS unsigned*)(flg + 1);
        asm volatile("s_waitcnt lgkmcnt(0)" ::: "memory");
        if (lane == 0) flg[16] = 1u;
        int nslot = 1;
        unsigned char* hp = CB.H0 + u0 * 8192 + it * 1024 + lane * 16;
#define SB_STEP(CH, MF, D, MFN, DN) { \
            f32x4 d_[4], a_[4]; \
            _Pragma("unroll") for (int jt = 0; jt < 4; ++jt) { d_[jt][0] = bflo(D[jt].x); d_[jt][1] = bfhi(D[jt].x); d_[jt][2] = bflo(D[jt].y); d_[jt][3] = bfhi(D[jt].y); } \
            u32x4 hb0, hb1; hb0.x = pk2(acc[0][0], acc[0][1]); hb0.y = pk2(acc[0][2], acc[0][3]); hb0.z = pk2(acc[1][0], acc[1][1]); hb0.w = pk2(acc[1][2], acc[1][3]); \
            _Pragma("unroll") for (int jt = 0; jt < 4; ++jt) a_[jt] = __builtin_amdgcn_mfma_f32_16x16x32_bf16(__builtin_bit_cast(bf16x8, MF[jt][0]), __builtin_bit_cast(bf16x8, hb0), d_[jt], 0, 0, 0); \
            __builtin_amdgcn_sched_barrier(0); \
            hb1.x = pk2(acc[2][0], acc[2][1]); hb1.y = pk2(acc[2][2], acc[2][3]); hb1.z = pk2(acc[3][0], acc[3][1]); hb1.w = pk2(acc[3][2], acc[3][3]); \
            __builtin_amdgcn_sched_barrier(0); \
            *(u32x4*)hp = hb0; *(u32x4*)(hp + 4096) = hb1; hp += 8192; \
            if ((CH) + 1 < 128) { \
                unsigned fu = (unsigned)__builtin_amdgcn_readfirstlane((int)f); \
                while (fu != (unsigned)((CH) + 2)) fu = lds_poll(flg + nslot); \
                asm volatile("" ::: "memory"); \
                SB_READ(MFN, DN, nslot); \
                nslot = (nslot == SB_DEPTH - 1) ? 0 : nslot + 1; \
                f = *(const volatile LAS unsigned*)(flg + nslot); \
            } \
            __builtin_amdgcn_sched_barrier(0); \
            _Pragma("unroll") for (int jt = 0; jt < 4; ++jt) acc[jt] = __builtin_amdgcn_mfma_f32_16x16x32_bf16(__builtin_bit_cast(bf16x8, MF[jt][1]), __builtin_bit_cast(bf16x8, hb1), a_[jt], 0, 0, 0); \
            __builtin_amdgcn_sched_barrier(0); \
            if ((CH) + 1 < 128) { asm volatile("s_waitcnt lgkmcnt(0)" ::: "memory"); if (lane == 0) flg[16] = (unsigned)((CH) + 2); }        \
        }
        for (int ch = 0; ch < 128; ch += 2) {
            SB_STEP(ch, mfA, dA, mfB, dB)
            SB_STEP(ch + 1, mfB, dB, mfA, dA)
        }
#undef SB_STEP
#undef SB_READ
    } else {
        const int lw = wv - 1;
        int slot = lw, slot_f = lw, k = 0;
        for (int c = lw; c < 128; c += SB_NL, ++k) {
            if (c >= SB_DEPTH) { const unsigned need = (unsigned)(c - SB_DEPTH + 1); while (lds_poll(flg + 16) < need) __builtin_amdgcn_s_sleep(1); }
            asm volatile("" ::: "memory");
            sb_issue(CB.MQ + (u0 + c) * 16384, CB.DG + (u0 + c) * 8192, it, lane, lds0 + slot * SB_SLOT);
            slot += SB_NL; if (slot >= SB_DEPTH) slot -= SB_DEPTH;
            if (k >= SB_Q - 1) { wait_vm<10 * (SB_Q - 1)>();
                if (lane == 0) flg[slot_f] = (unsigned)(c - (SB_Q - 1) * SB_NL + 1);
                slot_f += SB_NL; if (slot_f >= SB_DEPTH) slot_f -= SB_DEPTH; }
        }
        const int clast = lw + (k - 1) * SB_NL;
#define SB_DRAIN(q) if (k > (q)) { wait_vm<10 * (q)>(); if (lane == 0) flg[slot_f] = (unsigned)(clast - (q) * SB_NL + 1); slot_f += SB_NL; if (slot_f >= SB_DEPTH) slot_f -= SB_DEPTH; }
        SB_DRAIN(4) SB_DRAIN(3) SB_DRAIN(2) SB_DRAIN(1) SB_DRAIN(0)
#undef SB_DRAIN
        static_assert(SB_Q == 6, "drain sequence is written for SB_Q = 6");
    }
    }
}

__device__ __forceinline__ float xsum_rows(float v, int lane) {
    v += __builtin_bit_cast(float, __builtin_amdgcn_ds_bpermute((lane ^ 16) << 2, __builtin_bit_cast(int, v)));
    v += __builtin_bit_cast(float, __builtin_amdgcn_ds_bpermute((lane ^ 32) << 2, __builtin_bit_cast(int, v)));
    return v;
}
__device__ __forceinline__ void p_chunkC(const Params& P, const bf16* proj, const ChunkBufs& CB, bf16* ymix, unsigned char* lds_, const int wv) {
    const int tid_ = wv * 64 + lane_fresh();
    const int h = wv, lane = tid_ & 63, fr = lane & 15, fq = lane >> 4;
    LAS unsigned char* GL0 = (LAS unsigned char*)lds_ + h * 16384 + lane * 16;
#pragma unroll
    for (int ks = 0; ks < 4; ++ks)
#pragma unroll
        for (int it = 0; it < 4; ++it) *(LAS bf16x8*)(GL0 + (ks * 4 + it) * 1024) = *(const bf16x8*)(CB.GLT + (size_t)(h * 64 + it * 16 + fr) * 128 + 32 * ks + 8 * fq);
    for (int k_ = 0; ; ++k_) {
        const int grp = blockIdx.x + gridDim.x * (k_ >> 2), tile = grp * 4 + (k_ & 3);
        if (grp >= NTOK / 64) break;
        const int lane_ = lane_fresh();
        const int lane = lane_, fr = lane & 15, fq = lane >> 4;
        const LAS unsigned char* GL = (const LAS unsigned char*)lds_ + h * 16384 + lane * 16;
        const int tq = tile & 3, ch = (tile >> 2) & 127, b = tile >> 9;
        const size_t unit = (size_t)(b * 8 + h) * 128 + ch;
        const size_t rowbase = (size_t)b * SEQ + ch * 64;
        const int t = tq * 16 + fr; const size_t row = rowbase + t;
        const bool first = (ch == 0 && t == 0);
        const size_t prow = first ? row : row - 1;
        const unsigned char* uYI = CB.YI + unit * 8192; const unsigned char* uMQ = CB.MQ + unit * 16384; const unsigned char* uH0 = CB.H0 + unit * 8192;
        f32x4 acc[4], gacc[4]; u32x4 qf[2], hf[4], sg[4];
#pragma unroll
        for (int it = 0; it < 4; ++it) { const u32x2 yr = *(const u32x2*)(uYI + (tq * 4 + it) * 512 + lane * 8); acc[it][0] = bflo(yr.x); acc[it][1] = bfhi(yr.x); acc[it][2] = bflo(yr.y); acc[it][3] = bfhi(yr.y); gacc[it] = (f32x4){0.f, 0.f, 0.f, 0.f}; }
#pragma unroll
        for (int ks = 0; ks < 2; ++ks) qf[ks] = *(const u32x4*)(uMQ + 8192 + t * 128 + (32 * ks + 8 * fq) * 2);
#pragma unroll
        for (int it = 0; it < 4; ++it) hf[it] = *(const u32x4*)(uH0 + it * 1024 + lane * 16);
#pragma unroll
        for (int ks = 0; ks < 4; ++ks) sg[ks] = *(const u32x4*)(CB.PRE + row * 256 + 128 + 32 * ks + 8 * fq);
        asm volatile("" ::: "memory");
#pragma unroll
        for (int it = 0; it < 4; ++it) acc[it] = __builtin_amdgcn_mfma_f32_16x16x32_bf16(__builtin_bit_cast(bf16x8, hf[it]), __builtin_bit_cast(bf16x8, qf[0]), acc[it], 0, 0, 0);
        asm volatile("" ::: "memory");
#pragma unroll
        for (int it = 0; it < 4; ++it) hf[it] = *(const u32x4*)(uH0 + (4 + it) * 1024 + lane * 16);
#pragma unroll
        for (int it = 0; it < 4; ++it) acc[it] = __builtin_amdgcn_mfma_f32_16x16x32_bf16(__builtin_bit_cast(bf16x8, hf[it]), __builtin_bit_cast(bf16x8, qf[1]), acc[it], 0, 0, 0);
#pragma unroll
        for (int ks = 0; ks < 4; ++ks) {
            asm volatile("" ::: "memory");
#pragma unroll
            for (int it = 0; it < 4; ++it) gacc[it] = __builtin_amdgcn_mfma_f32_16x16x32_bf16(*(const LAS bf16x8*)(GL + (ks * 4 + it) * 1024), __builtin_bit_cast(bf16x8, sg[ks]), gacc[it], 0, 0, 0);
        }
        float s = 0.f;
#pragma unroll
        for (int it = 0; it < 4; ++it) s += (acc[it][0] + acc[it][1]) + (acc[it][2] + acc[it][3]);
        s = xsum_rows(s, lane);
        const float mean = s * (1.f / 64.f);
        float q = 0.f;
#pragma unroll
        for (int it = 0; it < 4; ++it)
#pragma unroll
            for (int r = 0; r < 4; ++r) { const float d = acc[it][r] - mean; q += d * d; }
        q = xsum_rows(q, lane);
        const float rstd = 1.0f / sqrtf(q * (1.f / 64.f) + GN_EPS);
        asm volatile("" ::: "memory");
        u32x2 cv[4], pv[4];
#pragma unroll
        for (int it = 0; it < 4; ++it) { const int c = h * 64 + it * 16 + 4 * fq;
            cv[it] = *(const u32x2*)(proj + row * INC + 1024 + c); pv[it] = *(const u32x2*)(proj + prow * INC + 1024 + c); }
        const float bonus = CB.BON[row * 8 + h];
#pragma unroll
        for (int it = 0; it < 4; ++it) {
            const int c = h * 64 + it * 16 + 4 * fq;
            const float cvf[4] = {bflo(cv[it].x), bfhi(cv[it].x), bflo(cv[it].y), bfhi(cv[it].y)};
            const float pvf[4] = {first ? 0.f : bflo(pv[it].x), first ? 0.f : bfhi(pv[it].x), first ? 0.f : bflo(pv[it].y), first ? 0.f : bfhi(pv[it].y)};
            const f32x4 lg = *(const f32x4*)(P.lnx_g + c), lb = *(const f32x4*)(P.lnx_b + c), muv = *(const f32x4*)(P.rwkv_mu + 1024 + c);
            float o[4];
#pragma unroll
            for (int r = 0; r < 4; ++r) { const float v = cvf[r] + (pvf[r] - cvf[r]) * muv[r]; const float yn = (acc[it][r] - mean) * rstd * lg[r] + lb[r]; o[r] = (yn + bonus * v) * gacc[it][r]; }
            u32x2 w; w.x = pk2(o[0], o[1]); w.y = pk2(o[2], o[3]);
            *(u32x2*)(ymix + row * DM + c) = w;
        }
    }
}

struct AttnRaw { u32x4 k[3], v[3], q[2][2]; };
__device__ __forceinline__ void attn_issue(AttnRaw& R, const bf16* proj, int item, int tid, int wave, int lane) {
    const int kvh = item & 1, tile = (item >> 1) & 127, b = item >> 8, t0 = tile * 64, dc = tid & 7, fr = lane & 15, fq = lane >> 4;
    const size_t brow = (size_t)b * SEQ;
#pragma unroll
    for (int pass = 0; pass < 3; ++pass) {
        const int key = t0 - 128 + pass * 64 + (tid >> 3);
        const bf16* kp = proj + (brow + (key < 0 ? 0 : key)) * INC + 2304 + kvh * 64 + dc * 8;
        R.k[pass] = *(const u32x4*)kp; R.v[pass] = *(const u32x4*)(kp + 128);
    }
    const int head = kvh * 4 + (wave & 3);
#pragma unroll
    for (int qt = 0; qt < 2; ++qt)
#pragma unroll
        for (int ks = 0; ks < 2; ++ks) R.q[qt][ks] = *(const u32x4*)(proj + (brow + t0 + (wave >> 2) * 32 + qt * 16 + fr) * INC + RCOLS + head * 64 + 32 * ks + 8 * fq);
}
__device__ __forceinline__ void p_attn3(const Params& P, const bf16* proj, bf16* ymix, unsigned char* lds_, int first_blk, int nblk, int item_lo, int item_hi, const int wv) {
    if ((int)blockIdx.x < first_blk || (int)blockIdx.x >= first_blk + nblk) return;
    LAS unsigned char* L = (LAS unsigned char*)lds_;
    constexpr int KLD = 72, VLD = 200, O_KN = 0, O_VT = 192 * KLD * 2, O_BT = O_VT + 64 * VLD * 2, O_GK = O_BT + 4096, O_GQ = O_GK + 256;
    const int NITEM = item_hi;
    const int tid_ = wv * 64 + lane_fresh();
    const int tid = tid_, wave = wv, lane = tid & 63, fr = lane & 15, fq = lane >> 4, hq = wave & 3, qh = wave >> 2;
    LAS float* btab = (LAS float*)(L + O_BT);
    for (int i = tid_; i < 1024; i += 512) { const int dist = i & 127, hw = (i >> 7) & 3, kv = i >> 9; btab[i] = 1.4426950408889634f * P.rel_bias[(int)T5B[dist] * 8 + kv * 4 + hw]; }
    if (tid_ < 64) { *(LAS float*)(L + O_GK + tid_ * 4) = P.k_norm_g[tid_]; *(LAS float*)(L + O_GQ + tid_ * 4) = P.q_norm_g[tid_]; }
    float gqm = fabsf(P.q_norm_g[lane]), gkm = fabsf(P.k_norm_g[lane]);
    float bm0 = (lane < 32) ? fabsf(P.rel_bias[lane * 8 + hq]) : 0.f, bm1 = (lane < 32) ? fabsf(P.rel_bias[lane * 8 + 4 + hq]) : 0.f;
#pragma unroll
    for (int o = 1; o < 64; o <<= 1) { gqm = fmaxf(gqm, __shfl_xor(gqm, o)); gkm = fmaxf(gkm, __shfl_xor(gkm, o)); bm0 = fmaxf(bm0, __shfl_xor(bm0, o)); bm1 = fmaxf(bm1, __shfl_xor(bm1, o)); }
    const float mref0 = 8.0f * gqm * gkm + bm0, mref1 = 8.0f * gqm * gkm + bm1;
    const float sink0 = P.sinks[hq], sink1 = P.sinks[4 + hq];
    AttnRaw cur, nxt;
    const int item0 = item_lo + (int)blockIdx.x - first_blk;
    if (item0 < NITEM) attn_issue(cur, proj, item0, tid, wave, lane);
    for (int item = item0; item < NITEM; item += nblk) {
        const int kvh = item & 1, tile = (item >> 1) & 127, b = item >> 8, t0 = tile * 64, head = kvh * 4 + hq;
        const size_t brow = (size_t)b * SEQ;
        __syncthreads();
        { const int dc = tid & 7;
          const f32x4 g0 = *(const LAS f32x4*)(L + O_GK + dc * 32), g1 = *(const LAS f32x4*)(L + O_GK + dc * 32 + 16);
#pragma unroll
          for (int pass = 0; pass < 3; ++pass) {
              const int kl = pass * 64 + (tid >> 3), key = t0 - 128 + kl;
              const u32x4 zero4 = (u32x4){0u, 0u, 0u, 0u};
              const u32x4 raw = (key >= 0) ? cur.k[pass] : zero4, vraw = (key >= 0) ? cur.v[pass] : zero4;
              float f[8]; float ss = 0.f;
#pragma unroll
              for (int e = 0; e < 4; ++e) { f[2 * e] = bflo(raw[e]); f[2 * e + 1] = bfhi(raw[e]); ss += f[2 * e] * f[2 * e] + f[2 * e + 1] * f[2 * e + 1]; }
              ss = sum8(ss);
              const float rs = 1.0f / sqrtf(ss * (1.f / 64.f) + NORM_EPS);
              u32x4 o; o.x = pk2(f[0] * rs * g0[0], f[1] * rs * g0[1]); o.y = pk2(f[2] * rs * g0[2], f[3] * rs * g0[3]); o.z = pk2(f[4] * rs * g1[0], f[5] * rs * g1[1]); o.w = pk2(f[6] * rs * g1[2], f[7] * rs * g1[3]);
              *(LAS u32x4*)(L + O_KN + (kl * KLD + dc * 8) * 2) = o;
#pragma unroll
              for (int e = 0; e < 4; ++e) { *(LAS unsigned short*)(L + O_VT + ((dc * 8 + 2 * e) * VLD + kl) * 2) = (unsigned short)(vraw[e] & 0xffffu); *(LAS unsigned short*)(L + O_VT + ((dc * 8 + 2 * e + 1) * VLD + kl) * 2) = (unsigned short)(vraw[e] >> 16); }
          } }
        const float MREF = kvh ? mref1 : mref0;
        const float sinkterm = fexp((kvh ? sink1 : sink0) - MREF);
        const u32x4 q00 = cur.q[0][0], q01 = cur.q[0][1], q10 = cur.q[1][0], q11 = cur.q[1][1];
        if (item + nblk < NITEM) attn_issue(nxt, proj, item + nblk, tid, wave, lane);
        __syncthreads();
#pragma unroll 1
        for (int qt = 0; qt < 2; ++qt) {
            const int tq0 = qh * 32 + qt * 16, tq = tq0 + fr, kt0 = tq0 >> 4;
            const size_t row = brow + t0 + tq;
            bf16x8 qfrag[2];
            { u32x4 qraw[2]; qraw[0] = qt ? q10 : q00; qraw[1] = qt ? q11 : q01; float ss = 0.f;
#pragma unroll
              for (int ks = 0; ks < 2; ++ks) {
#pragma unroll
                  for (int e = 0; e < 4; ++e) { const float lo = bflo(qraw[ks][e]), hi = bfhi(qraw[ks][e]); ss += lo * lo + hi * hi; } }
              ss += __shfl_xor(ss, 16); ss += __shfl_xor(ss, 32);
              const float rs = (0.125f * 1.4426950408889634f) / sqrtf(ss * (1.f / 64.f) + NORM_EPS);
#pragma unroll
              for (int ks = 0; ks < 2; ++ks) { const f32x4 g0 = *(const LAS f32x4*)(L + O_GQ + (32 * ks + 8 * fq) * 4), g1 = *(const LAS f32x4*)(L + O_GQ + (32 * ks + 8 * fq + 4) * 4);
                  u32x4 o; o.x = pk2(bflo(qraw[ks][0]) * rs * g0[0], bfhi(qraw[ks][0]) * rs * g0[1]); o.y = pk2(bflo(qraw[ks][1]) * rs * g0[2], bfhi(qraw[ks][1]) * rs * g0[3]);
                  o.z = pk2(bflo(qraw[ks][2]) * rs * g1[0], bfhi(qraw[ks][2]) * rs * g1[1]); o.w = pk2(bflo(qraw[ks][3]) * rs * g1[2], bfhi(qraw[ks][3]) * rs * g1[3]);
                  qfrag[ks] = __builtin_bit_cast(bf16x8, o); } }
            u32x2 ppk[9]; float lsum = 0.f;
            const float nm = -1.4426950408889634f * MREF;
            const f32x4 sinit = (f32x4){nm, nm, nm, nm};
            const LAS float* bt = btab + kvh * 512 + hq * 128 + (128 + fr - 4 * fq);
            const bool lowt = (t0 < 128);
#pragma unroll
            for (int m = 0; m < 9; ++m) {
                const int kt = kt0 + m;
                f32x4 s = sinit;
#pragma unroll
                for (int ks = 0; ks < 2; ++ks) { const bf16x8 kf = *(const LAS bf16x8*)(L + O_KN + ((16 * kt + fr) * KLD + 32 * ks + 8 * fq) * 2); s = __builtin_amdgcn_mfma_f32_16x16x32_bf16(kf, qfrag[ks], s, 0, 0, 0); }
                float p[4];
#pragma unroll
                for (int r = 0; r < 4; ++r) {
                    const int doff = 16 * m + r;
                    float pv = __builtin_amdgcn_exp2f(s[r] + bt[-doff]);
                    if (m == 0) pv = (fr < 4 * fq + r) ? pv : 0.f;
                    if (m == 8) pv = (fr >= 4 * fq + r) ? pv : 0.f;
                    if (lowt) pv = (t0 - 128 + 16 * kt + 4 * fq + r >= 0) ? pv : 0.f;
                    p[r] = pv; lsum += pv; }
                ppk[m].x = pk2(p[0], p[1]); ppk[m].y = pk2(p[2], p[3]);
            }
            f32x4 o[4];
#pragma unroll
            for (int dt = 0; dt < 4; ++dt) o[dt] = (f32x4){0.f, 0.f, 0.f, 0.f};
#pragma unroll
            for (int mm = 0; mm < 5; ++mm) {
                u32x4 pf; pf.x = ppk[2 * mm].x; pf.y = ppk[2 * mm].y;
                if (mm < 4) { pf.z = ppk[2 * mm + 1].x; pf.w = ppk[2 * mm + 1].y; } else { pf.z = 0u; pf.w = 0u; }
#pragma unroll
                for (int dt = 0; dt < 4; ++dt) {
                    const LAS unsigned char* vp = L + O_VT + ((16 * dt + fr) * VLD + 16 * (kt0 + 2 * mm) + 4 * fq) * 2;
                    const u32x2 v0 = *(const LAS u32x2*)vp; u32x2 v1; v1.x = 0u; v1.y = 0u;
                    if (mm < 4) v1 = *(const LAS u32x2*)(vp + 32);
                    u32x4 vf; vf.x = v0.x; vf.y = v0.y; vf.z = v1.x; vf.w = v1.y;
                    o[dt] = __builtin_amdgcn_mfma_f32_16x16x32_bf16(__builtin_bit_cast(bf16x8, vf), __builtin_bit_cast(bf16x8, pf), o[dt], 0, 0, 0);
                }
            }
            lsum += __shfl_xor(lsum, 16); lsum += __shfl_xor(lsum, 32);
            const float inv = 1.0f / (lsum + sinkterm);
#pragma unroll
            for (int dt = 0; dt < 4; ++dt) { u32x2 w; w.x = pk2(o[dt][0] * inv, o[dt][1] * inv); w.y = pk2(o[dt][2] * inv, o[dt][3] * inv);
                *(u32x2*)(ymix + row * DM + 512 + head * 64 + 16 * dt + 4 * fq) = w; }
        }
        cur = nxt;
    }
}

constexpr int LDS_BYTES = 163840;
#define GRID_SYNC() xcd_barrier(bar)
__global__ void __launch_bounds__(512, 2) fwd_megakernel(Params P) {
    extern __shared__ __attribute__((aligned(16))) unsigned char lds[];
    cg::grid_group grid = cg::this_grid();
    const int wv = __builtin_amdgcn_readfirstlane((int)(threadIdx.x >> 6));
    float* ldsf = (float*)lds;
    volatile LAS unsigned* MISC = (volatile LAS unsigned*)((LAS unsigned char*)lds + LDS_BYTES - 256);
    if (threadIdx.x < 32) MISC[threadIdx.x] = 0u;
    __syncthreads();
    XcdBarrier bar = xcd_barrier_post((unsigned*)(P.ws + WS_CTL) + 4096, MISC + 8, wv);
    unsigned char* ws = P.ws; float* out = P.out;
    float* mod = (float*)(ws + WS_MOD); float* SSQ = (float*)(ws + WS_SSQ); float* CGU = (float*)(ws + WS_CGU); float* C1 = (float*)(ws + WS_C1); float* RSTD1 = (float*)(ws + WS_RSTD1);
    bf16* Win_t = (bf16*)(ws + WS_WIN); bf16* Wout_t = (bf16*)(ws + WS_WOUT); bf16* Wgu_t = (bf16*)(ws + WS_WGU); bf16* Wdn_t = (bf16*)(ws + WS_WDN);
    bf16* H1 = (bf16*)(ws + WS_XB); bf16* PROJ = (bf16*)(ws + WS_PROJ); bf16* YMIX = (bf16*)(ws + WS_YMIX); bf16* H2 = (bf16*)(ws + WS_H2); bf16* ACT = (bf16*)(ws + WS_PROJ);
    ChunkBufs CB; CB.DG = (unsigned char*)out; CB.YI = (unsigned char*)out + (size_t)32 * MiB; CB.MQ = (unsigned char*)out + (size_t)64 * MiB; CB.H0 = ws + WS_H2; CB.BON = (float*)(ws + WS_BON); CB.PRE = (const bf16*)(ws + WS_PRE);
    CB.WLT = (const bf16*)(ws + WS_LORA); CB.ALT = CB.WLT + 512 * 64; CB.GLT = CB.ALT + 512 * 64;

    float* par = (float*)(ws + WS_PAR);
    { const int gt = blockIdx.x * 512 + wv * 64 + lane_fresh();
      if (gt < 1792) par[PO_MU + gt] = P.rwkv_mu[gt];
      if (gt < 512) { par[PO_W0 + gt] = P.w0[gt]; par[PO_A0 + gt] = P.a0[gt]; par[PO_KK + gt] = P.k_k[gt]; par[PO_KA + gt] = P.k_a[gt]; par[PO_RK + gt] = P.r_k[gt]; par[PO_LG + gt] = P.lnx_g[gt]; par[PO_LB + gt] = P.lnx_b[gt]; }
      if (gt < 64) { par[PO_QG + gt] = P.q_norm_g[gt]; par[PO_KG + gt] = P.k_norm_g[gt]; }
      if (gt < 8) par[PO_SINK + gt] = P.sinks[gt];
      if (gt < 256) par[PO_RB + gt] = P.rel_bias[gt];
      if (gt < 1024) { par[PO_N1 + gt] = P.norm1_g[gt]; par[PO_N2 + gt] = P.norm2_g[gt]; } }
    p_mod(P, mod, ldsf, wv);
    p_xb(P.x, H1, RSTD1, wv);
    p_transposes(P, Win_t, Wout_t, Wgu_t, Wdn_t, (bf16*)CB.WLT, (bf16*)CB.ALT, (bf16*)CB.GLT, ldsf, wv);
    if (gridDim.y == 0x7fff) grid.sync();
    GRID_SYNC();
    p_fold(P.w_in, P.w_gate, P.w_up, par + PO_N1, par + PO_N2, mod, Win_t, C1, Wgu_t, CGU, ldsf, wv);
    GRID_SYNC();
    { pg8::Gemm g; g.A = H1; g.Bt = Win_t; g.M = NTOK; g.N = INC; g.K = DM; g.pad = 0; g.bstride = (size_t)INC * DM * 2; pg8::StaticOrder S; S.init(NTOK, INC, gridDim.x, blockIdx.x, 2);
      EpiStoreBf16Norm E; E.O = PROJ; E.rstd = RSTD1; E.cvec = C1; E.ldc = INC; E.pad = 0;
      pg8::gemm_phase<EpiStoreBf16Norm, pg8::StaticOrder, true, true>((PG8_LAS unsigned char*)lds, g, S, E, wv); }
    GRID_SYNC();
    const Params Q = { P.x, nullptr, nullptr, nullptr, nullptr, nullptr, par + PO_MU, par + PO_W0, nullptr, par + PO_A0, nullptr, nullptr, par + PO_KK, par + PO_KA, par + PO_RK, par + PO_LG, par + PO_LB,
                       par + PO_QG, par + PO_KG, par + PO_SINK, par + PO_RB, nullptr, nullptr, nullptr, nullptr, nullptr, nullptr, nullptr };
    p_pre(Q, PROJ, (bf16*)(ws + WS_PRE), wv);
    p_attn3(Q, PROJ, YMIX, lds, 0, gridDim.x, 0, 512, wv);
    GRID_SYNC();
    p_chunkA(Q, PROJ, CB, lds, wv);
    GRID_SYNC();
    p_chunkB(CB, lds, wv);
    { const int fb = (gridDim.x >= 256) ? 128 : 0;
      p_attn3(Q, PROJ, YMIX, lds, fb, gridDim.x - fb, 512, 1024, wv); }
    GRID_SYNC();
    p_chunkC(Q, PROJ, CB, YMIX, lds, wv);
    GRID_SYNC();
    { pg8::Gemm g; g.A = YMIX; g.Bt = Wout_t; g.M = NTOK; g.N = DM; g.K = DM; g.pad = 0; g.bstride = 0; pg8::StaticOrder S; S.init(NTOK, DM, gridDim.x, blockIdx.x);
      EpiResidNormB E; E.base = H1; E.gate = mod + 2 * DM; E.hb = H2; E.ssq = SSQ;
      pg8::gemm_phase<EpiResidNormB, pg8::StaticOrder, true, true>((PG8_LAS unsigned char*)lds, g, S, E, wv); }
    GRID_SYNC();
    { pg8::Gemm g; g.A = H2; g.Bt = Wgu_t; g.M = NTOK; g.N = 2 * DFF; g.K = DM; g.pad = 0; g.bstride = (size_t)2 * DFF * DM * 2; pg8::StaticOrder S; S.init(NTOK, 2 * DFF, gridDim.x, blockIdx.x);
      EpiSwigluNorm E; E.act = ACT; E.ssq = SSQ; E.cgu = CGU;
      pg8::gemm_phase<EpiSwigluNorm, pg8::StaticOrder, true, true>((PG8_LAS unsigned char*)lds, g, S, E, wv); }
    GRID_SYNC();
    { pg8::Gemm g; g.A = ACT; g.Bt = Wdn_t; g.M = NTOK; g.N = DM; g.K = DFF; g.pad = 0; g.bstride = 0; pg8::StaticOrder S; S.init(NTOK, DM, gridDim.x, blockIdx.x);
      EpiFinalB E; E.hb = H2; E.out = out; E.gate = mod + 5 * DM;
      pg8::gemm_phase<EpiFinalB, pg8::StaticOrder, true, true>((PG8_LAS unsigned char*)lds, g, S, E, wv); }
}

extern "C" void kernel_launch(void* const* d_in, const int* in_sizes, int n_in, void* d_out, int out_size, void* d_ws, size_t ws_size, hipStream_t stream) {
    static int grid_blocks = 0;
    if (grid_blocks == 0) {
        if (n_in != 26 || in_sizes[0] != NTOK * DM || out_size != NTOK * DM || ws_size < WS_END) { fprintf(stderr, "kernel_launch: unexpected shapes (n_in %d, ws %zu)\n", n_in, ws_size); grid_blocks = -1; return; }
        int dev = 0, cus = 0, per_cu = 0;
        (void)hipGetDevice(&dev);
        (void)hipDeviceGetAttribute(&cus, hipDeviceAttributeMultiprocessorCount, dev);
        if (hipFuncSetAttribute((const void*)fwd_megakernel, hipFuncAttributeMaxDynamicSharedMemorySize, LDS_BYTES) != hipSuccess) { fprintf(stderr, "kernel_launch: hipFuncSetAttribute failed\n"); grid_blocks = -1; return; }
        if (hipOccupancyMaxActiveBlocksPerMultiprocessor(&per_cu, (const void*)fwd_megakernel, 512, LDS_BYTES) != hipSuccess || per_cu < 1) { fprintf(stderr, "kernel_launch: occupancy query failed (%d)\n", per_cu); grid_blocks = -1; return; }
        grid_blocks = cus * 1;
    }
    if (grid_blocks < 0) return;
    (void)hipMemsetAsync((unsigned char*)d_ws + WS_CTL, 0, CTL_ZERO_BYTES, stream);
    Params p; memset(&p, 0, sizeof(p));
    const float** pp = (const float**)&p;
    for (int i = 0; i < 26; ++i) pp[i] = (const float*)d_in[i];
    p.out = (float*)d_out; p.ws = (unsigned char*)d_ws;
    void* args[] = {&p};
    hipError_t e = hipLaunchCooperativeKernel((const void*)fwd_megakernel, dim3(grid_blocks), dim3(512), args, LDS_BYTES, stream);
    if (e != hipSuccess) fprintf(stderr, "cooperative launch failed: %s (grid %d)\n", hipGetErrorString(e), grid_blocks);
}
```

```cpp
#include <hip/hip_runtime.h>
#include <hip/hip_cooperative_groups.h>
#include <cstdio>
#include <cstdint>
#include <cstring>
namespace pg8 {
#define PG8_LAS __attribute__((address_space(3)))
typedef unsigned short bf16_t;
typedef short bf16x8 __attribute__((ext_vector_type(8)));
typedef float f32x4 __attribute__((ext_vector_type(4)));
typedef unsigned u32x4 __attribute__((ext_vector_type(4)));
constexpr int BM = 256, BK = 64, HALF = 128, HTB = HALF * BK * 2  , STAGE_BYTES = 8 * HTB, NXCD = 8, WGM = 8;

__host__ __device__ __forceinline__ int lds_byte(int r, int c) { const int st = (r >> 4) * 2 + (c >> 5), rr = r & 15, cc = c & 31, ob = rr * 64 + cc * 2; return st * 1024 + (ob ^ (((ob >> 9) & 1) << 5)); }
__host__ __device__ __forceinline__ void stage_rc(int b, int& R, int& C) { const int st = b / 1024, sb = b % 1024, swz = sb ^ (((sb >> 9) & 1) << 5); R = (st >> 1) * 16 + swz / 64; C = (st & 1) * 32 + (swz % 64) / 2; }
__host__ __device__ __forceinline__ int perm32(int rho) { const int n = rho >> 4, i = rho & 15; return 8 * (i >> 2) + 4 * n + (i & 3); }

struct Unit { int pm, pn; };
struct Gemm { const bf16_t* A; const bf16_t* Bt; int M, N, K, pad; size_t bstride; };

struct StaticOrder {
    int nM, nN, nwg, G, c, wgm;
    __host__ __device__ void init(int M, int N, int G_, int c_, int wgm_ = WGM) { nM = M / BM; nN = N / BM; nwg = nM * nN; G = G_; c = c_; wgm = wgm_; }
    __host__ __device__ bool next(int i, Unit& u) const {
        const long L = (long)i * G + c; if (L >= nwg) return false;
        int wgid = (int)L; { const int q = nwg / NXCD, r = nwg % NXCD, xcd = wgid % NXCD, off = wgid / NXCD; wgid = (xcd < r ? xcd * (q + 1) : r * (q + 1) + (xcd - r) * q) + off; }
        const int nig = wgm * nN, gid = wgid / nig, fm = gid * wgm, gsz = (nM - fm) < wgm ? (nM - fm) : wgm;
        u.pm = fm + ((wgid % nig) % gsz); u.pn = (wgid % nig) / gsz; return true;
    }
    __device__ __forceinline__ void a_ready(const Unit&) const {}
    __device__ __forceinline__ void done(const Unit&) const {}
};

__device__ __forceinline__ unsigned cvt_pk_bf16(float lo, float hi) { unsigned r; asm volatile("v_cvt_pk_bf16_f32 %0, %1, %2" : "=v"(r) : "v"(lo), "v"(hi)); return r; }
struct NoPre {};
template <class E, bool H> struct PreOf { typedef NoPre type; };
template <class E> struct PreOf<E, true> { typedef typename E::Pre type; };
template <class Epi, class Sched, bool ALIGN_EPI = false, bool SP2 = false>
__device__ __forceinline__ void gemm_phase(PG8_LAS unsigned char* lds, const Gemm g, const Sched& S, const Epi& E, const int wv) {
    int lane__; asm volatile("v_mbcnt_lo_u32_b32 %0, -1, 0\n\tv_mbcnt_hi_u32_b32 %0, -1, %0" : "=v"(lane__)); const int tid_ = wv * 64 + lane__;
    const int tid = tid_, wid = __builtin_amdgcn_readfirstlane(tid >> 6), lane = tid & 63, wr = wid >> 2, wc = wid & 3, fr = lane & 15, fq = lane >> 4;
    const int K = g.K, nt = K / BK;
    unsigned voffA[2], voffB[2];
#pragma unroll
    for (int i = 0; i < 2; ++i) { int R, C; stage_rc(tid * 16 + i * 8192, R, C); const int Rb = Epi::PERM ? ((R & ~31) + perm32(R & 31)) : R;
        voffA[i] = (unsigned)(R * K + C) * 2u; voffB[i] = (unsigned)(Rb * K + C) * 2u; }
    const size_t kstep = (size_t)(BK * 2);
    const size_t hstep = (size_t)HALF * K * 2;
    const size_t tstep = 2 * hstep;
    const unsigned ldsw = (unsigned)wid * 1024u;
    const int aoff = lds_byte(wr * 64 + fr, fq * 8), boff = lds_byte(wc * 32 + fr, fq * 8);
#define PG8_SA(b, h) (((b) * 2 + (h)) * HTB)
#define PG8_SB(b, h) ((4 + (b) * 2 + (h)) * HTB)
#define PG8_STAGE(bufoff, gbase, voff) do { _Pragma("unroll") for (int _i = 0; _i < 2; ++_i) \
        __builtin_amdgcn_global_load_lds((const unsigned*)((const char*)(gbase) + (voff)[_i]), (PG8_LAS unsigned*)(lds + (bufoff) + ldsw + _i * 8192), 16, 0, 0); } while (0)
#define PG8_LDA(dst, b, h) do { _Pragma("unroll") for (int m = 0; m < 4; ++m) _Pragma("unroll") for (int k = 0; k < 2; ++k) dst[m][k] = *(const PG8_LAS bf16x8*)(lds + PG8_SA(b, h) + aoff + m * 2048 + k * 1024); } while (0)
#define PG8_LDB(dst, b, h) do { _Pragma("unroll") for (int n = 0; n < 2; ++n) _Pragma("unroll") for (int k = 0; k < 2; ++k) dst[n][k] = *(const PG8_LAS bf16x8*)(lds + PG8_SB(b, h) + boff + n * 2048 + k * 1024); } while (0)
#define PG8_MMA(ai, bj, At, Bt) do { __builtin_amdgcn_s_setprio(1); _Pragma("unroll") for (int m = 0; m < 4; ++m) _Pragma("unroll") for (int n = 0; n < 2; ++n) _Pragma("unroll") for (int k = 0; k < 2; ++k) \
        acc[ai][bj][m][n] = __builtin_amdgcn_mfma_f32_16x16x32_bf16(Bt[n][k], At[m][k], acc[ai][bj][m][n], 0, 0, 0); __builtin_amdgcn_s_setprio(0); } while (0)
#define PG8_WAIT_V(n) asm volatile("s_waitcnt vmcnt(" #n ")" ::: "memory")
#define PG8_WAIT_L(n) asm volatile("s_waitcnt lgkmcnt(" #n ")" ::: "memory")
#define PG8_BAR __builtin_amdgcn_s_barrier()
#define PG8_SCHED __builtin_amdgcn_sched_barrier(0)
    Unit cur, nxt; int ui = 0;
    if (!S.next(0, cur)) return;
    PG8_LAS float* epl = (PG8_LAS float*)(lds + STAGE_BYTES) + wid * 256;
    typename PreOf<Epi, Epi::HAS_PRE>::type p0;
    if constexpr (Epi::HAS_PRE) E.pre_load(p0, cur, wr, wc, fr, fq);
    f32x4 acc[2][2][4][2];
#pragma unroll
    for (int a = 0; a < 2; ++a)
#pragma unroll
        for (int b = 0; b < 2; ++b)
#pragma unroll
            for (int m = 0; m < 4; ++m)
#pragma unroll
                for (int n = 0; n < 2; ++n) acc[a][b][m][n] = (f32x4){0.f, 0.f, 0.f, 0.f};
    bf16x8 At[4][2], B0[2][2], B1[2][2];
    const char* cA = (const char*)g.A + (size_t)cur.pm * tstep; const char* cB = (const char*)g.Bt + (size_t)cur.pn * tstep + (size_t)(cur.pm >> 5) * g.bstride;
    S.a_ready(cur);
    if constexpr (SP2) {
        PG8_STAGE(PG8_SB(0, 0), cB, voffB); PG8_STAGE(PG8_SB(0, 1), cB + hstep, voffB); PG8_STAGE(PG8_SA(0, 0), cA, voffA); PG8_STAGE(PG8_SA(0, 1), cA + hstep, voffA);
        if (wr == 1) PG8_BAR;
        PG8_WAIT_V(2); PG8_BAR;
        if constexpr (Epi::HAS_PRE) E.pre_store(p0, fr, fq, epl);
        PG8_STAGE(PG8_SB(1, 0), cB + kstep, voffB); PG8_STAGE(PG8_SA(1, 0), cA + kstep, voffA); PG8_STAGE(PG8_SB(1, 1), cB + hstep + kstep, voffB);
        PG8_WAIT_V(6); PG8_BAR;
    } else {
        PG8_STAGE(PG8_SB(0, 0), cB, voffB); PG8_STAGE(PG8_SA(0, 0), cA, voffA); PG8_STAGE(PG8_SB(0, 1), cB + hstep, voffB); PG8_STAGE(PG8_SA(0, 1), cA + hstep, voffA);
        if (wr == 1) PG8_BAR;
        PG8_WAIT_V(4); PG8_BAR;
        if constexpr (Epi::HAS_PRE) E.pre_store(p0, fr, fq, epl);
        PG8_STAGE(PG8_SB(1, 0), cB + kstep, voffB); PG8_STAGE(PG8_SA(1, 0), cA + kstep, voffA); PG8_STAGE(PG8_SB(1, 1), cB + hstep + kstep, voffB);
        PG8_WAIT_V(6); PG8_BAR;
    }
    for (;;) {
        const bool has_next = S.next(ui + 1, nxt);
        const char* nA = has_next ? (const char*)g.A + (size_t)nxt.pm * tstep : cA; const char* nB = has_next ? (const char*)g.Bt + (size_t)nxt.pn * tstep + (size_t)(nxt.pm >> 5) * g.bstride : cB;
        for (int t = 0; t < nt; t += 2) {
            const bool last = (t == nt - 2);
            const char* a1 = cA + (size_t)(t + 1) * kstep;
            const char* a2 = last ? nA : cA + (size_t)(t + 2) * kstep; const char* b2 = last ? nB : cB + (size_t)(t + 2) * kstep;
            const char* a3 = a2 + kstep; const char* b3 = b2 + kstep;
            if (last && has_next) S.a_ready(nxt);
            if constexpr (SP2) {
            PG8_LDB(B0, 0, 0); PG8_LDB(B1, 0, 1); PG8_SCHED; PG8_LDA(At, 0, 0); PG8_STAGE(PG8_SA(1, 1), a1 + hstep, voffA);
            PG8_WAIT_V(8); PG8_WAIT_L(0); PG8_BAR; PG8_MMA(0, 0, At, B0); PG8_MMA(0, 1, At, B1); PG8_BAR; PG8_SCHED;
            PG8_LDA(At, 0, 1); PG8_STAGE(PG8_SB(0, 0), b2, voffB); PG8_STAGE(PG8_SB(0, 1), b2 + hstep, voffB); PG8_STAGE(PG8_SA(0, 0), a2, voffA);
            PG8_WAIT_V(8); PG8_WAIT_L(0); PG8_BAR; PG8_MMA(1, 0, At, B0); PG8_MMA(1, 1, At, B1); PG8_BAR; PG8_SCHED;
            PG8_LDB(B0, 1, 0); PG8_LDB(B1, 1, 1); PG8_SCHED; PG8_LDA(At, 1, 0); PG8_STAGE(PG8_SA(0, 1), a2 + hstep, voffA);
            PG8_WAIT_V(8); PG8_WAIT_L(0); PG8_BAR; PG8_MMA(0, 0, At, B0); PG8_MMA(0, 1, At, B1); PG8_BAR; PG8_SCHED;
            PG8_LDA(At, 1, 1); PG8_STAGE(PG8_SB(1, 0), b3, voffB); PG8_STAGE(PG8_SB(1, 1), b3 + hstep, voffB); PG8_STAGE(PG8_SA(1, 0), a3, voffA);
            PG8_WAIT_V(8); PG8_WAIT_L(0); PG8_BAR; PG8_MMA(1, 0, At, B0); PG8_MMA(1, 1, At, B1); PG8_BAR; PG8_SCHED;
            } else {
            PG8_LDB(B0, 0, 0); PG8_SCHED; PG8_LDA(At, 0, 0); PG8_STAGE(PG8_SA(1, 1), a1 + hstep, voffA);
            PG8_WAIT_L(8); PG8_BAR; PG8_WAIT_L(0); PG8_MMA(0, 0, At, B0); PG8_BAR; PG8_SCHED;
            PG8_LDB(B1, 0, 1); PG8_STAGE(PG8_SB(0, 0), b2, voffB);
            PG8_BAR; PG8_WAIT_L(0); PG8_MMA(0, 1, At, B1); PG8_BAR;
            PG8_LDA(At, 0, 1); PG8_STAGE(PG8_SA(0, 0), a2, voffA);
            PG8_BAR; PG8_WAIT_L(0); PG8_MMA(1, 0, At, B0); PG8_BAR; PG8_SCHED;
            PG8_STAGE(PG8_SB(0, 1), b2 + hstep, voffB);
            PG8_WAIT_V(6); PG8_BAR; PG8_MMA(1, 1, At, B1); PG8_BAR;
            PG8_LDB(B0, 1, 0); PG8_SCHED; PG8_LDA(At, 1, 0); PG8_STAGE(PG8_SA(0, 1), a2 + hstep, voffA);
            PG8_WAIT_L(8); PG8_BAR; PG8_WAIT_L(0); PG8_MMA(0, 0, At, B0); PG8_BAR; PG8_SCHED;
            PG8_LDB(B1, 1, 1); PG8_STAGE(PG8_SB(1, 0), b3, voffB);
            PG8_BAR; PG8_WAIT_L(0); PG8_MMA(0, 1, At, B1); PG8_BAR;
            PG8_LDA(At, 1, 1); PG8_STAGE(PG8_SA(1, 0), a3, voffA);
            PG8_BAR; PG8_WAIT_L(0); PG8_MMA(1, 0, At, B0); PG8_BAR; PG8_SCHED;
            PG8_STAGE(PG8_SB(1, 1), b3 + hstep, voffB);
            PG8_WAIT_V(6); PG8_BAR; PG8_MMA(1, 1, At, B1); PG8_BAR;
            }
        }
        if constexpr (ALIGN_EPI) { if (wr == 0) PG8_BAR; }
        if constexpr (!Epi::AFTER_DRAIN) {
            if constexpr (Epi::HAS_PRE) { typename Epi::Pre pn; if (has_next) E.pre_load(pn, nxt, wr, wc, fr, fq);
                E(acc, cur, wr, wc, fr, fq, epl);
                if (has_next) E.pre_store(pn, fr, fq, epl); }
            else E(acc, cur, wr, wc, fr, fq);
            S.done(cur); }
        if (!has_next) break;
#pragma unroll
        for (int a = 0; a < 2; ++a)
#pragma unroll
            for (int b = 0; b < 2; ++b)
#pragma unroll
                for (int m = 0; m < 4; ++m)
#pragma unroll
                    for (int n = 0; n < 2; ++n) acc[a][b][m][n] = (f32x4){0.f, 0.f, 0.f, 0.f};
        cur = nxt; cA = nA; cB = nB; ++ui;
        if constexpr (ALIGN_EPI) { if (wr == 1) PG8_BAR; }
    }
    PG8_WAIT_V(0);
    if constexpr (!ALIGN_EPI) { if (wr == 0) PG8_BAR; }
    PG8_BAR;
    if constexpr (Epi::AFTER_DRAIN) { E.fused(acc, cur, wr, wc, fr, fq, lds, wid, lane); S.done(cur); }
#undef PG8_SA
#undef PG8_SB
#undef PG8_STAGE
#undef PG8_LDA
#undef PG8_LDB
#undef PG8_MMA
#undef PG8_WAIT_V
#undef PG8_WAIT_L
#undef PG8_BAR
#undef PG8_SCHED
}
}

constexpr int BATCH = 4, SEQ = 8192, NTOK = BATCH * SEQ, DM = 1024, INC = 2560, RW = 512, RCOLS = 1792, DFF = 2816, NMOD = 6 * DM;
constexpr float NORM_EPS = 1e-6f, GN_EPS = 64e-5f;
typedef unsigned short bf16;
typedef float f32x4 __attribute__((ext_vector_type(4)));
typedef unsigned u32x4 __attribute__((ext_vector_type(4)));
typedef unsigned u32x2 __attribute__((ext_vector_type(2)));
#define LAS __attribute__((address_space(3)))

typedef float f32x2_t __attribute__((ext_vector_type(2))); typedef __bf16 bf16x2_t __attribute__((ext_vector_type(2)));
__device__ __forceinline__ unsigned pk2(float lo, float hi) { f32x2_t v = {lo, hi}; bf16x2_t b = __builtin_convertvector(v, bf16x2_t); return __builtin_bit_cast(unsigned, b); }
__device__ __forceinline__ unsigned f2bf(float f) { return pk2(f, 0.f) & 0xffffu; }
__device__ __forceinline__ int lane_fresh() { int l; asm volatile("v_mbcnt_lo_u32_b32 %0, -1, 0\n\tv_mbcnt_hi_u32_b32 %0, -1, %0" : "=v"(l)); return l; }
__device__ __forceinline__ float bf2f(bf16 v) { return __builtin_bit_cast(float, (unsigned)v << 16); }
__device__ __forceinline__ float rows_sum(float v) {
    auto a = __builtin_amdgcn_permlane16_swap(__builtin_bit_cast(unsigned, v), __builtin_bit_cast(unsigned, v), false, false);
    v = __builtin_bit_cast(float, a[0]) + __builtin_bit_cast(float, a[1]);
    auto b = __builtin_amdgcn_permlane32_swap(__builtin_bit_cast(unsigned, v), __builtin_bit_cast(unsigned, v), false, false);
    return __builtin_bit_cast(float, b[0]) + __builtin_bit_cast(float, b[1]);
}
__device__ __forceinline__ float wave_sum(float v) {
#pragma unroll
    for (int o = 1; o < 64; o <<= 1) v += __shfl_xor(v, o);
    return v;
}
__device__ __forceinline__ float sigmoidf_(float x) { return 1.0f / (1.0f + expf(-x)); }
__device__ __forceinline__ float siluf_(float x) { return x / (1.0f + expf(-x)); }
__device__ __forceinline__ float softplusf_(float x) { return fmaxf(x, 0.f) + log1pf(expf(-fabsf(x))); }

__constant__ unsigned char T5B[128] = {0, 1, 2, 3, 4, 5, 6, 7, 8, 9, 10, 11, 12, 13, 14, 15, 16, 16, 16, 17, 17, 18, 18, 18, 19, 19, 19, 20, 20, 20, 20, 21, 21, 21, 21, 22, 22, 22, 22, 22, 23, 23, 23, 23, 23, 23, 24, 24, 24, 24, 24, 24, 25, 25, 25, 25, 25, 25, 25, 26, 26, 26, 26, 26, 26, 26, 26, 27, 27, 27, 27, 27, 27, 27, 27, 27, 27, 28, 28, 28, 28, 28, 28, 28, 28, 28, 28, 29, 29, 29, 29, 29, 29, 29, 29, 29, 29, 29, 29, 30, 30, 30, 30, 30, 30, 30, 30, 30, 30, 30, 30, 30, 30, 31, 31, 31, 31, 31, 31, 31, 31, 31, 31, 31, 31, 31, 31, 31};

constexpr size_t MiB = 1u << 20;
constexpr size_t WS_CTL = 0, CTL_ZERO_BYTES = 1 * MiB;
constexpr size_t WS_MOD = 256 * 1024;
constexpr size_t WS_SSQ = 512 * 1024;
constexpr size_t WS_CGU = 640 * 1024;
constexpr size_t WS_WIN = 2 * MiB;
constexpr size_t WS_WOUT = 22 * MiB;
constexpr size_t WS_WGU = 24 * MiB;
constexpr size_t WS_WDN = 68 * MiB;
constexpr size_t WS_C1 = 832 * 1024;
constexpr size_t WS_RSTD1 = 1 * MiB;
constexpr size_t WS_PAR = 768 * 1024;
constexpr int PO_MU = 0, PO_W0 = 1792, PO_A0 = 2304, PO_KK = 2816, PO_KA = 3328, PO_RK = 3840, PO_LG = 4352, PO_LB = 4864, PO_QG = 5376, PO_KG = 5440, PO_SINK = 5504, PO_RB = 5512, PO_N1 = 5768, PO_N2 = 6792;
constexpr size_t WS_LORA = 74 * MiB;
constexpr size_t WS_XB = 76 * MiB;
constexpr size_t WS_PROJ = 140 * MiB;
constexpr size_t WS_YMIX = 300 * MiB;
constexpr size_t WS_H2 = 364 * MiB;
constexpr size_t WS_PRE = 428 * MiB;
constexpr size_t WS_BON = 492 * MiB;
constexpr size_t WS_END = 494 * MiB;
#define XB_TMO      128
#define XB_XCNT(j)  (256  + 64 * (j))
#define XB_XSUB(j)  (1280 + 64 * (j))
#define XB_XGEN(j)  (2304 + 64 * (j))
#define XB_TOP      3328
#define XB_TOPGEN   3392
#define XCD_BAR_WORDS 3456
#define XB_SPIN_CAP (1u << 18)


__device__ __forceinline__ unsigned xb_ld(unsigned* p)              { return __hip_atomic_load(p, __ATOMIC_RELAXED, __HIP_MEMORY_SCOPE_AGENT); }
__device__ __forceinline__ unsigned xb_add(unsigned* p, unsigned v) { return __hip_atomic_fetch_add(p, v, __ATOMIC_RELAXED, __HIP_MEMORY_SCOPE_AGENT); }
__device__ __forceinline__ unsigned xb_xcc_id() { return (unsigned)__builtin_amdgcn_s_getreg((3 << 11) | 20) & 0xFu; }
#define XB_SPIN(cond, bar) do { unsigned _sp = 0; while (cond) { __builtin_amdgcn_s_sleep(1); \
    if ((++_sp & 255u) == 0u) { if (xb_ld(&(bar)[XB_TMO])) break; if (_sp > XB_SPIN_CAP) { atomicAdd(&(bar)[XB_TMO], 1u); break; } } } } while (0)

struct XcdBarrier {
    int wv;
    unsigned* bar; unsigned x;
    volatile LAS unsigned* st;
};

__device__ __forceinline__ XcdBarrier xcd_barrier_post(unsigned* bar, volatile LAS unsigned* st, int wv) {
    XcdBarrier b; b.wv = wv; b.bar = bar; b.x = xb_xcc_id(); b.st = st;
    if (wv == 0 && lane_fresh() == 0) (void)xb_add(&bar[XB_XCNT(b.x)], 1u);
    return b;
}
__device__ __forceinline__ void xcd_barrier_complete(unsigned* bar, unsigned x, unsigned& nloc, unsigned& nx) {
    const unsigned G = gridDim.x * gridDim.y * gridDim.z;
    unsigned sum, cnt, mine, sp = 0u;
    for (;;) {
        sum = 0u; cnt = 0u; mine = 0u;
#pragma unroll
        for (unsigned j = 0; j < 16; ++j) { const unsigned c = xb_ld(&bar[XB_XCNT(j)]); sum += c; cnt += (c > 0u) ? 1u : 0u; mine = (j == x) ? c : mine; }
        if (sum == G) break;
        __builtin_amdgcn_s_sleep(1);
        if ((++sp & 255u) == 0u) { if (xb_ld(&bar[XB_TMO])) break; if (sp > XB_SPIN_CAP) { atomicAdd(&bar[XB_TMO], 1u); break; } }
    }
    nloc = mine > 0u ? mine : 1u; nx = cnt > 0u ? cnt : 1u;
}

__device__ __forceinline__ void xcd_barrier(const XcdBarrier& b) {
    asm volatile("s_waitcnt vmcnt(0)" ::: "memory");
    __syncthreads();
    if (b.wv == 0 && lane_fresh() == 0) {
        unsigned* bar = b.bar;
        __builtin_amdgcn_s_waitcnt(0);
        unsigned nloc = b.st[0], nx = b.st[1];
        if (nloc == 0u) { xcd_barrier_complete(bar, b.x, nloc, nx); b.st[0] = nloc; b.st[1] = nx; }
        const unsigned old = xb_add(&bar[XB_XSUB(b.x)], 1u);
        const unsigned gen = old / nloc;
        if (old + 1u == (gen + 1u) * nloc) {
            __builtin_amdgcn_fence(__ATOMIC_RELEASE, "agent");
            asm volatile("s_waitcnt vmcnt(0)" ::: "memory");
            const unsigned og = xb_add(&bar[XB_TOP], 1u);
            const unsigned tg = og / nx;
            if (og + 1u == (tg + 1u) * nx) xb_add(&bar[XB_TOPGEN], 1u);
            else XB_SPIN(xb_ld(&bar[XB_TOPGEN]) == tg, bar);
            __builtin_amdgcn_fence(__ATOMIC_ACQUIRE, "agent");
            xb_add(&bar[XB_XGEN(b.x)], 1u);
            asm volatile("s_waitcnt vmcnt(0)" ::: "memory");
        } else {
            XB_SPIN(xb_ld(&bar[XB_XGEN(b.x)]) == gen, bar);
            __builtin_amdgcn_fence(__ATOMIC_ACQUIRE, "agent");
            asm volatile("s_waitcnt vmcnt(0)" ::: "memory");
        }
    }
    __syncthreads();
}
using pg8::Unit;
struct EpiStoreBf16 {
    static constexpr bool PERM = true, AFTER_DRAIN = false, HAS_PRE = false;
    bf16* O; int ldc; int pad;
    __device__ __forceinline__ void operator()(const f32x4 (&acc)[2][2][4][2], const Unit& u, int wr, int wc, int fr, int fq) const {
        const int row0 = u.pm * 256 + wr * 64 + fr, col0 = u.pn * 256 + wc * 32 + 8 * fq;
#pragma unroll
        for (int ai = 0; ai < 2; ++ai)
#pragma unroll
            for (int m = 0; m < 4; ++m) { bf16* rowp = O + (size_t)(row0 + ai * 128 + m * 16) * ldc + col0;
#pragma unroll
                for (int bj = 0; bj < 2; ++bj) { const f32x4 v0 = acc[ai][bj][m][0], v1 = acc[ai][bj][m][1]; u32x4 w;
                    w.x = pg8::cvt_pk_bf16(v0[0], v0[1]); w.y = pg8::cvt_pk_bf16(v0[2], v0[3]); w.z = pg8::cvt_pk_bf16(v1[0], v1[1]); w.w = pg8::cvt_pk_bf16(v1[2], v1[3]);
                    *(u32x4*)(rowp + bj * 128) = w; } }
    }
};
struct EpiResid {
    static constexpr bool PERM = false, AFTER_DRAIN = false, HAS_PRE = false;
    const float* base; float* out; const float* gate;
    __device__ __forceinline__ void operator()(const f32x4 (&acc)[2][2][4][2], const Unit& u, int wr, int wc, int fr, int fq) const {
        const int b = u.pm >> 5, col0 = u.pn * 256 + wc * 32 + 4 * fq;
#pragma unroll
        for (int bj = 0; bj < 2; ++bj)
#pragma unroll
            for (int n = 0; n < 2; ++n) { const f32x4 gv = *(const f32x4*)(gate + b * NMOD + col0 + bj * 128 + n * 16);
#pragma unroll
                for (int ai = 0; ai < 2; ++ai)
#pragma unroll
                    for (int m = 0; m < 4; ++m) { const size_t off = (size_t)(u.pm * 256 + ai * 128 + wr * 64 + m * 16 + fr) * DM + col0 + bj * 128 + n * 16;
                        const f32x4 bs = *(const f32x4*)(base + off); *(f32x4*)(out + off) = bs + gv * acc[ai][bj][m][n]; } }
    }
};
struct EpiSwiglu {
    static constexpr bool PERM = true, AFTER_DRAIN = false, HAS_PRE = false;
    bf16* act;
    __device__ __forceinline__ void operator()(const f32x4 (&acc)[2][2][4][2], const Unit& u, int wr, int wc, int fr, int fq) const {
        const int row0 = u.pm * 256 + wr * 64 + fr, col0 = u.pn * 128 + wc * 32 + 8 * fq;
#pragma unroll
        for (int ai = 0; ai < 2; ++ai)
#pragma unroll
            for (int m = 0; m < 4; ++m) { const f32x4 g0 = acc[ai][0][m][0], g1 = acc[ai][0][m][1], u0 = acc[ai][1][m][0], u1 = acc[ai][1][m][1]; float r[8];
#pragma unroll
                for (int e = 0; e < 4; ++e) { r[e] = g0[e] * __builtin_amdgcn_rcpf(1.0f + __builtin_amdgcn_exp2f(-1.4426950408889634f * g0[e])) * u0[e]; r[4 + e] = g1[e] * __builtin_amdgcn_rcpf(1.0f + __builtin_amdgcn_exp2f(-1.4426950408889634f * g1[e])) * u1[e]; }
                u32x4 w; w.x = pg8::cvt_pk_bf16(r[0], r[1]); w.y = pg8::cvt_pk_bf16(r[2], r[3]); w.z = pg8::cvt_pk_bf16(r[4], r[5]); w.w = pg8::cvt_pk_bf16(r[6], r[7]);
                *(u32x4*)(act + (size_t)(row0 + ai * 128 + m * 16) * DFF + col0) = w; }
    }
};


struct EpiResidNorm {
    static constexpr bool PERM = false, AFTER_DRAIN = false, HAS_PRE = false;
    const float* base; float* out; const float* gate; bf16* hb; float* ssq;
    __device__ __forceinline__ void operator()(const f32x4 (&acc)[2][2][4][2], const Unit& u, int wr, int wc, int fr, int fq) const {
        const int b = u.pm >> 5, col0 = u.pn * 256 + wc * 32 + 4 * fq;
        f32x4 gv[2][2];
#pragma unroll
        for (int bj = 0; bj < 2; ++bj)
#pragma unroll
            for (int n = 0; n < 2; ++n) gv[bj][n] = *(const f32x4*)(gate + b * NMOD + col0 + bj * 128 + n * 16);
#pragma unroll
        for (int ai = 0; ai < 2; ++ai)
#pragma unroll
            for (int m = 0; m < 4; ++m) {
                const int row = u.pm * 256 + ai * 128 + wr * 64 + m * 16 + fr; float sq = 0.f;
#pragma unroll
                for (int bj = 0; bj < 2; ++bj)
#pragma unroll
                    for (int n = 0; n < 2; ++n) { const size_t off = (size_t)row * DM + col0 + bj * 128 + n * 16;
                        const f32x4 hv = *(const f32x4*)(base + off) + gv[bj][n] * acc[ai][bj][m][n];
                        *(f32x4*)(out + off) = hv;
                        u32x2 w; w.x = pg8::cvt_pk_bf16(hv[0], hv[1]); w.y = pg8::cvt_pk_bf16(hv[2], hv[3]); *(u32x2*)(hb + off) = w;
                        sq += (hv[0] * hv[0] + hv[1] * hv[1]) + (hv[2] * hv[2] + hv[3] * hv[3]); }
                sq += __shfl_xor(sq, 16); sq += __shfl_xor(sq, 32);
                if (fq == 0) atomicAdd(ssq + row, sq);
            }
    }
};
struct EpiSwigluNorm {
    static constexpr bool PERM = true, AFTER_DRAIN = false, HAS_PRE = true;
    bf16* act; const float* ssq; const float* cgu;
    struct Pre { float rs[8]; f32x4 cv[4]; };
    __device__ __forceinline__ void pre_load(Pre& p, const Unit& u, int wr, int wc, int fr, int fq) const {
        const int row0 = u.pm * 256 + wr * 64 + fr, b = u.pm >> 5;
#pragma unroll
        for (int k = 0; k < 8; ++k) p.rs[k] = ssq[row0 + (k >> 2) * 128 + (k & 3) * 16];
        const float* cg = cgu + (size_t)b * (2 * DFF) + u.pn * 256 + wc * 32 + 8 * fq;
        p.cv[0] = *(const f32x4*)(cg); p.cv[1] = *(const f32x4*)(cg + 4); p.cv[2] = *(const f32x4*)(cg + 128); p.cv[3] = *(const f32x4*)(cg + 132);
    }
    __device__ __forceinline__ void pre_store(const Pre& p, int fr, int fq, PG8_LAS float* epl) const {
        if (fq == 0) {
#pragma unroll
            for (int k = 0; k < 8; ++k) epl[k * 16 + fr] = p.rs[k]; }
        if (fr == 0) {
#pragma unroll
            for (int j = 0; j < 4; ++j) *(PG8_LAS f32x4*)(epl + 128 + (j * 4 + fq) * 4) = p.cv[j]; }
    }
    __device__ __forceinline__ void operator()(const f32x4 (&acc)[2][2][4][2], const Unit& u, int wr, int wc, int fr, int fq, const PG8_LAS float* epl) const {
        const int row0 = u.pm * 256 + wr * 64 + fr, col0 = u.pn * 128 + wc * 32 + 8 * fq;
        const f32x4 cg0 = *(const PG8_LAS f32x4*)(epl + 128 + (0 * 4 + fq) * 4), cg1 = *(const PG8_LAS f32x4*)(epl + 128 + (1 * 4 + fq) * 4), cu0 = *(const PG8_LAS f32x4*)(epl + 128 + (2 * 4 + fq) * 4), cu1 = *(const PG8_LAS f32x4*)(epl + 128 + (3 * 4 + fq) * 4);
#pragma unroll
        for (int ai = 0; ai < 2; ++ai)
#pragma unroll
            for (int m = 0; m < 4; ++m) { const int row = row0 + ai * 128 + m * 16;
                const float rstd = 1.0f / sqrtf(epl[(ai * 4 + m) * 16 + fr] * (1.f / DM) + NORM_EPS);
                const f32x4 g0 = acc[ai][0][m][0] * rstd + cg0, g1 = acc[ai][0][m][1] * rstd + cg1, u0 = acc[ai][1][m][0] * rstd + cu0, u1 = acc[ai][1][m][1] * rstd + cu1; float r[8];
#pragma unroll
                for (int e = 0; e < 4; ++e) { r[e] = g0[e] * __builtin_amdgcn_rcpf(1.0f + __builtin_amdgcn_exp2f(-1.4426950408889634f * g0[e])) * u0[e]; r[4 + e] = g1[e] * __builtin_amdgcn_rcpf(1.0f + __builtin_amdgcn_exp2f(-1.4426950408889634f * g1[e])) * u1[e]; }
                u32x4 w; w.x = pg8::cvt_pk_bf16(r[0], r[1]); w.y = pg8::cvt_pk_bf16(r[2], r[3]); w.z = pg8::cvt_pk_bf16(r[4], r[5]); w.w = pg8::cvt_pk_bf16(r[6], r[7]);
                __builtin_nontemporal_store(w, (u32x4*)(act + (size_t)row * DFF + col0)); }
    }
};

struct EpiResidNormB {
    static constexpr bool PERM = true, AFTER_DRAIN = false, HAS_PRE = false;
    const bf16* base; const float* gate; bf16* hb; float* ssq;
    __device__ __forceinline__ void operator()(const f32x4 (&acc)[2][2][4][2], const Unit& u, int wr, int wc, int fr, int fq) const {
        const int b = u.pm >> 5, col0 = u.pn * 256 + wc * 32 + 8 * fq;
        f32x4 gv[2][2];
#pragma unroll
        for (int bj = 0; bj < 2; ++bj)
#pragma unroll
            for (int n = 0; n < 2; ++n) gv[bj][n] = *(const f32x4*)(gate + b * NMOD + col0 + bj * 128 + n * 4);
        const size_t rbase = (size_t)(u.pm * 256 + wr * 64 + fr) * DM + col0;
#define RES_OFF(r_) (rbase + (size_t)(((r_) >> 2) * 128 + ((r_) & 3) * 16) * DM)
        u32x4 xw[4][2];
#pragma unroll
        for (int r = 0; r < 4; ++r)
#pragma unroll
            for (int bj = 0; bj < 2; ++bj) xw[r][bj] = __builtin_nontemporal_load((const u32x4*)(base + RES_OFF(r) + bj * 128));
#pragma unroll
        for (int r = 0; r < 8; ++r) {
            const int ai = r >> 2, m = r & 3;
            const int row = u.pm * 256 + ai * 128 + wr * 64 + m * 16 + fr; float sq = 0.f;
#pragma unroll
            for (int bj = 0; bj < 2; ++bj) { const size_t off = RES_OFF(r) + bj * 128;
                const u32x4 xv = xw[r & 3][bj];
                f32x4 x0, x1; x0[0] = __builtin_bit_cast(float, xv.x << 16); x0[1] = __builtin_bit_cast(float, xv.x & 0xffff0000u); x0[2] = __builtin_bit_cast(float, xv.y << 16); x0[3] = __builtin_bit_cast(float, xv.y & 0xffff0000u);
                x1[0] = __builtin_bit_cast(float, xv.z << 16); x1[1] = __builtin_bit_cast(float, xv.z & 0xffff0000u); x1[2] = __builtin_bit_cast(float, xv.w << 16); x1[3] = __builtin_bit_cast(float, xv.w & 0xffff0000u);
                const f32x4 h0 = x0 + gv[bj][0] * acc[ai][bj][m][0], h1 = x1 + gv[bj][1] * acc[ai][bj][m][1];
                u32x4 w; w.x = pg8::cvt_pk_bf16(h0[0], h0[1]); w.y = pg8::cvt_pk_bf16(h0[2], h0[3]); w.z = pg8::cvt_pk_bf16(h1[0], h1[1]); w.w = pg8::cvt_pk_bf16(h1[2], h1[3]);
                *(u32x4*)(hb + off) = w;
                sq += ((h0[0] * h0[0] + h0[1] * h0[1]) + (h0[2] * h0[2] + h0[3] * h0[3])) + ((h1[0] * h1[0] + h1[1] * h1[1]) + (h1[2] * h1[2] + h1[3] * h1[3])); }
            if (r + 4 < 8) {
#pragma unroll
                for (int bj = 0; bj < 2; ++bj) xw[r & 3][bj] = __builtin_nontemporal_load((const u32x4*)(base + RES_OFF(r + 4) + bj * 128)); }
            sq += __shfl_xor(sq, 16); sq += __shfl_xor(sq, 32);
            if (fq == 0) atomicAdd(ssq + row, sq);
        }
#undef RES_OFF
    }
};
struct EpiFinalB {
    static constexpr bool PERM = true, AFTER_DRAIN = false, HAS_PRE = false;
    const bf16* hb; float* out; const float* gate;
    __device__ __forceinline__ void operator()(const f32x4 (&acc)[2][2][4][2], const Unit& u, int wr, int wc, int fr, int fq) const {
        const int b = u.pm >> 5, col0 = u.pn * 256 + wc * 32 + 8 * fq;
        f32x4 gv[2][2];
#pragma unroll
        for (int bj = 0; bj < 2; ++bj)
#pragma unroll
            for (int n = 0; n < 2; ++n) gv[bj][n] = *(const f32x4*)(gate + b * NMOD + col0 + bj * 128 + n * 4);
#pragma unroll
        for (int ai = 0; ai < 2; ++ai)
#pragma unroll
            for (int m = 0; m < 4; ++m) {
                const int row = u.pm * 256 + ai * 128 + wr * 64 + m * 16 + fr;
#pragma unroll
                for (int bj = 0; bj < 2; ++bj) { const size_t off = (size_t)row * DM + col0 + bj * 128;
                    const u32x4 hv = __builtin_nontemporal_load((const u32x4*)(hb + off));
                    f32x4 o0, o1;
                    o0[0] = __builtin_bit_cast(float, hv.x << 16); o0[1] = __builtin_bit_cast(float, hv.x & 0xffff0000u); o0[2] = __builtin_bit_cast(float, hv.y << 16); o0[3] = __builtin_bit_cast(float, hv.y & 0xffff0000u);
                    o1[0] = __builtin_bit_cast(float, hv.z << 16); o1[1] = __builtin_bit_cast(float, hv.z & 0xffff0000u); o1[2] = __builtin_bit_cast(float, hv.w << 16); o1[3] = __builtin_bit_cast(float, hv.w & 0xffff0000u);
                    __builtin_nontemporal_store(o0 + gv[bj][0] * acc[ai][bj][m][0], (f32x4*)(out + off)); __builtin_nontemporal_store(o1 + gv[bj][1] * acc[ai][bj][m][1], (f32x4*)(out + off + 4)); }
            }
    }
};

struct EpiStoreBf16Norm {
    static constexpr bool PERM = true, AFTER_DRAIN = false, HAS_PRE = true;
    bf16* O; const float* rstd; const float* cvec; int ldc; int pad;
    struct Pre { float rs[8]; f32x4 cv[4]; };
    __device__ __forceinline__ void pre_load(Pre& p, const Unit& u, int wr, int wc, int fr, int fq) const {
        const int row0 = u.pm * 256 + wr * 64 + fr, col0 = u.pn * 256 + wc * 32 + 8 * fq, b = u.pm >> 5;
#pragma unroll
        for (int k = 0; k < 8; ++k) p.rs[k] = rstd[row0 + (k >> 2) * 128 + (k & 3) * 16];
#pragma unroll
        for (int j = 0; j < 4; ++j) p.cv[j] = *(const f32x4*)(cvec + (size_t)b * ldc + col0 + (j >> 1) * 128 + (j & 1) * 4);
    }
    __device__ __forceinline__ void pre_store(const Pre& p, int fr, int fq, PG8_LAS float* epl) const {
        if (fq == 0) {
#pragma unroll
            for (int k = 0; k < 8; ++k) epl[k * 16 + fr] = p.rs[k]; }
        if (fr == 0) {
#pragma unroll
            for (int j = 0; j < 4; ++j) *(PG8_LAS f32x4*)(epl + 128 + (j * 4 + fq) * 4) = p.cv[j]; }
    }
    __device__ __forceinline__ void operator()(const f32x4 (&acc)[2][2][4][2], const Unit& u, int wr, int wc, int fr, int fq, const PG8_LAS float* epl) const {
        const int row0 = u.pm * 256 + wr * 64 + fr, col0 = u.pn * 256 + wc * 32 + 8 * fq;
        f32x4 cv[2][2];
#pragma unroll
        for (int bj = 0; bj < 2; ++bj)
#pragma unroll
            for (int n = 0; n < 2; ++n) cv[bj][n] = *(const PG8_LAS f32x4*)(epl + 128 + ((bj * 2 + n) * 4 + fq) * 4);
#pragma unroll
        for (int ai = 0; ai < 2; ++ai)
#pragma unroll
            for (int m = 0; m < 4; ++m) { const int row = row0 + ai * 128 + m * 16; const float rs = epl[(ai * 4 + m) * 16 + fr]; bf16* rowp = O + (size_t)row * ldc + col0;
#pragma unroll
                for (int bj = 0; bj < 2; ++bj) { const f32x4 v0 = acc[ai][bj][m][0] * rs + cv[bj][0], v1 = acc[ai][bj][m][1] * rs + cv[bj][1]; u32x4 w;
                    w.x = pg8::cvt_pk_bf16(v0[0], v0[1]); w.y = pg8::cvt_pk_bf16(v0[2], v0[3]); w.z = pg8::cvt_pk_bf16(v1[0], v1[1]); w.w = pg8::cvt_pk_bf16(v1[2], v1[3]);
                    __builtin_nontemporal_store(w, (u32x4*)(rowp + bj * 128)); } }
    }
};

namespace cg = cooperative_groups;
struct Params {
    const float *x, *c, *w_ada, *b_ada, *norm1_g, *w_in, *rwkv_mu, *w0, *w_lora_up, *a0, *a_lora_up, *g_lora_up, *k_k, *k_a, *r_k, *lnx_g, *lnx_b,
                *q_norm_g, *k_norm_g, *sinks, *rel_bias, *w_out, *norm2_g, *w_gate, *w_up, *w_down;
    float* out; unsigned char* ws;
};
#define LDS_WAIT() asm volatile("s_waitcnt lgkmcnt(0)" ::: "memory")

__device__ __forceinline__ void p_mod(const Params& P, float* mod, float* lds, const int wv) {
    float (*sc)[64] = (float (*)[64])lds;
    const int tid = wv * 64 + lane_fresh();
    for (int it = blockIdx.x; it < 16 * 16; it += gridDim.x) {
        const int nb = it & 15, kc = it >> 4;
        const int n = nb * 384 + (tid < 384 ? tid : 0);
        float w[32];
#pragma unroll
        for (int k = 0; k < 32; ++k) w[k] = __builtin_nontemporal_load(P.w_ada + (size_t)(kc * 64 + k) * NMOD + n);
        __syncthreads();
        if (tid < 256) { const int b = tid >> 6, k = tid & 63; sc[b][k] = siluf_(P.c[b * DM + kc * 64 + k]); }
        __syncthreads();
        float a0 = 0.f, a1 = 0.f, a2 = 0.f, a3 = 0.f;
#pragma unroll
        for (int k = 0; k < 32; ++k) { a0 += sc[0][k] * w[k]; a1 += sc[1][k] * w[k]; a2 += sc[2][k] * w[k]; a3 += sc[3][k] * w[k]; }
#pragma unroll
        for (int k = 0; k < 32; ++k) w[k] = __builtin_nontemporal_load(P.w_ada + (size_t)(kc * 64 + 32 + k) * NMOD + n);
#pragma unroll
        for (int k = 0; k < 32; ++k) { a0 += sc[0][32 + k] * w[k]; a1 += sc[1][32 + k] * w[k]; a2 += sc[2][32 + k] * w[k]; a3 += sc[3][32 + k] * w[k]; }
        if (kc == 0) { const float bb = P.b_ada[n]; a0 += bb; a1 += bb; a2 += bb; a3 += bb; }
        if (tid < 384) { atomicAdd(mod + 0 * NMOD + n, a0); atomicAdd(mod + 1 * NMOD + n, a1); atomicAdd(mod + 2 * NMOD + n, a2); atomicAdd(mod + 3 * NMOD + n, a3); }
    }
}

__device__ __forceinline__ int rowmap(int n, int mode) { return mode == 0 ? n : ((n >> 7) * 256 + (mode == 2 ? 128 : 0) + (n & 127)); }
__device__ __forceinline__ void transpose_item(const float* W, int K, int N, bf16* WT, int mode, float* scr, int item, int lane) {
    const int nblk = N / 32, kb = item / nblk, nb = item % nblk, k0 = 64 * kb, n0 = 32 * nb;
    { float wv_[32];
#pragma unroll
      for (int i = 0; i < 32; ++i) wv_[i] = __builtin_nontemporal_load(W + (size_t)(k0 + 2 * i + (lane >> 5)) * N + n0 + (lane & 31));
#pragma unroll
      for (int i = 0; i < 32; ++i) scr[(2 * i + (lane >> 5)) * 33 + (lane & 31)] = wv_[i]; }
    LDS_WAIT();
    const int c = lane & 7;
#pragma unroll
    for (int j = 0; j < 4; ++j) { const int n = (lane >> 3) + 8 * j; const float* s = scr + (8 * c) * 33 + n;
        u32x4 o; o.x = pk2(s[0 * 33], s[1 * 33]); o.y = pk2(s[2 * 33], s[3 * 33]); o.z = pk2(s[4 * 33], s[5 * 33]); o.w = pk2(s[6 * 33], s[7 * 33]);
        *(u32x4*)(WT + (size_t)rowmap(n0 + n, mode) * K + k0 + 8 * c) = o; }
    LDS_WAIT();
}
__device__ __forceinline__ void p_transposes(const Params& P, bf16* Win_t, bf16* Wout_t, bf16* Wgu_t, bf16* Wdn_t, bf16* WLT, bf16* ALT, bf16* GLT, float* lds, const int wv) {
    const int wave = wv, lane = lane_fresh();
    float* scr = lds + 1024 + wave * (64 * 33);
    constexpr int I_IN = (DM / 64) * (INC / 32), I_OUT = (DM / 64) * (DM / 32), I_G = (DM / 64) * (DFF / 32), I_DN = (DFF / 64) * (DM / 32);
    constexpr int I_L = (64 / 64) * (RW / 32), I_GL = (128 / 64) * (RW / 32);
    constexpr int NIT = I_OUT + I_DN + 2 * I_L + I_GL;
    for (int it = blockIdx.x * 8 + wave; it < NIT; it += gridDim.x * 8) {
        int r = it;
        if (r < I_OUT) { transpose_item(P.w_out, DM, DM, Wout_t, 0, scr, r, lane); continue; } r -= I_OUT;
        if (r < I_DN) { transpose_item(P.w_down, DFF, DM, Wdn_t, 0, scr, r, lane); continue; } r -= I_DN;
        if (r < I_L) { transpose_item(P.w_lora_up, 64, RW, WLT, 0, scr, r, lane); continue; } r -= I_L;
        if (r < I_L) { transpose_item(P.a_lora_up, 64, RW, ALT, 0, scr, r, lane); continue; } r -= I_L;
        transpose_item(P.g_lora_up, 128, RW, GLT, 0, scr, r, lane);
    }
}

__device__ __forceinline__ void p_modnorm(const float* src, const float* g, const float* mod, int shift_off, int scale_off, bf16* dst, const int wv) {
    const int wave = wv, lane = lane_fresh();
    for (int row = blockIdx.x * 8 + wave; row < NTOK; row += gridDim.x * 8) {
        const int b = row >> 13;
        const f32x4* xr = (const f32x4*)(src + (size_t)row * DM) + lane;
        f32x4 v[4]; float s = 0.f;
#pragma unroll
        for (int j = 0; j < 4; ++j) { v[j] = xr[64 * j]; s += (v[j].x * v[j].x + v[j].y * v[j].y) + (v[j].z * v[j].z + v[j].w * v[j].w); }
        const float rstd = 1.0f / sqrtf(wave_sum(s) * (1.f / DM) + NORM_EPS);
        unsigned long long* o8 = (unsigned long long*)(dst + (size_t)row * DM) + lane;
#pragma unroll
        for (int j = 0; j < 4; ++j) {
            const int col = 4 * lane + 256 * j;
            const f32x4 gg = *(const f32x4*)(g + col), sc = *(const f32x4*)(mod + b * NMOD + scale_off + col), sh = *(const f32x4*)(mod + b * NMOD + shift_off + col);
            const f32x4 o = v[j] * rstd * gg * (sc + 1.0f) + sh;
            o8[64 * j] = (unsigned long long)pk2(o.x, o.y) | ((unsigned long long)pk2(o.z, o.w) << 32);
        }
    }
}


struct FoldRaw { float wv[32]; f32x4 vsc, vsh, vg; };
__device__ __forceinline__ void fold_issue(FoldRaw& R, const float* W, int N, const float* g, const float* mod, int shift_off, int scale_off, int item, int lane) {
    const int nblk = N / 32, kb = item / nblk, nb = item % nblk, k0 = 64 * kb, n0 = 32 * nb;
#pragma unroll
    for (int i = 0; i < 32; ++i) R.wv[i] = __builtin_nontemporal_load(W + (size_t)(k0 + 2 * i + (lane >> 5)) * N + n0 + (lane & 31));
    R.vsc = *(const f32x4*)(mod + (lane >> 4) * NMOD + scale_off + k0 + (lane & 15) * 4);
    R.vsh = *(const f32x4*)(mod + (lane >> 4) * NMOD + shift_off + k0 + (lane & 15) * 4);
    R.vg = *(const f32x4*)(g + k0 + (lane & 15) * 4);
}
__device__ __forceinline__ void fold_finish(const FoldRaw& R, int N, int NT, bf16* WT, float* cvec, int mode, float* scr, int item, int lane) {
    constexpr int K = DM;
    const int nblk = N / 32, kb = item / nblk, nb = item % nblk, k0 = 64 * kb, n0 = 32 * nb;
    float* aux = scr + 64 * 33;
#pragma unroll
    for (int i = 0; i < 32; ++i) scr[(2 * i + (lane >> 5)) * 33 + (lane & 31)] = R.wv[i];
    *(f32x4*)(aux + lane * 4) = R.vsc; *(f32x4*)(aux + 256 + lane * 4) = R.vsh; if (lane < 16) *(f32x4*)(aux + 512 + lane * 4) = R.vg;
    LDS_WAIT();
    const int c = lane & 7;
    const f32x4 g0_ = *(const f32x4*)(aux + 512 + 8 * c), g1_ = *(const f32x4*)(aux + 512 + 8 * c + 4);
#pragma unroll 1
    for (int b = 0; b < 4; ++b) {
        float G[8];
        { const f32x4 s0_ = *(const f32x4*)(aux + b * 64 + 8 * c), s1_ = *(const f32x4*)(aux + b * 64 + 8 * c + 4);
#pragma unroll
          for (int q = 0; q < 4; ++q) { G[q] = g0_[q] * (1.0f + s0_[q]); G[4 + q] = g1_[q] * (1.0f + s1_[q]); } }
#pragma unroll
        for (int j = 0; j < 4; ++j) { const int n = (lane >> 3) + 8 * j; const float* s = scr + (8 * c) * 33 + n;
            u32x4 o; o.x = pk2(s[0 * 33] * G[0], s[1 * 33] * G[1]); o.y = pk2(s[2 * 33] * G[2], s[3 * 33] * G[3]); o.z = pk2(s[4 * 33] * G[4], s[5 * 33] * G[5]); o.w = pk2(s[6 * 33] * G[6], s[7 * 33] * G[7]);
            *(u32x4*)(WT + (size_t)b * NT * K + (size_t)rowmap(n0 + n, mode) * K + k0 + 8 * c) = o; }
        const float* sh = aux + 256 + b * 64 + (lane >> 5) * 32;
        float a = 0.f;
#pragma unroll
        for (int q4 = 0; q4 < 8; ++q4) { const f32x4 hv = *(const f32x4*)(sh + 4 * q4);
#pragma unroll
            for (int e = 0; e < 4; ++e) a += hv[e] * scr[((lane >> 5) * 32 + 4 * q4 + e) * 33 + (lane & 31)]; }
        a += __shfl_xor(a, 32);
        if (lane < 32) atomicAdd(cvec + (size_t)b * NT + rowmap(n0 + lane, mode), a);
    }
    LDS_WAIT();
}
#define FOLD_DISPATCH(it, CALL_G, CALL_U, CALL_I) { if ((it) < I_G) { CALL_G; } else if ((it) < 2 * I_G) { CALL_U; } else { CALL_I; } }
__device__ __forceinline__ void p_fold(const float* w_in, const float* w_gate, const float* w_up, const float* g1, const float* g2, const float* mod, bf16* Win_b, float* c1, bf16* Wgu_b, float* cgu, float* lds, const int wv) {
    const int wave = wv, lane = lane_fresh();
    float* scr = lds + 1024 + wave * (64 * 33 + 576);
    constexpr int I_G = (DM / 64) * (DFF / 32), I_IN = (DM / 64) * (INC / 32), NITM = 2 * I_G + I_IN;
    const int step = gridDim.x * 8;
    for (int it = blockIdx.x * 8 + wave; it < NITM; it += 2 * step) {
        const int it2 = it + step; const bool two = it2 < NITM;
        FoldRaw RA, RB;
        FOLD_DISPATCH(it, fold_issue(RA, w_gate, DFF, g2, mod, 3 * DM, 4 * DM, it, lane), fold_issue(RA, w_up, DFF, g2, mod, 3 * DM, 4 * DM, it - I_G, lane), fold_issue(RA, w_in, INC, g1, mod, 0, DM, it - 2 * I_G, lane))
        if (two) FOLD_DISPATCH(it2, fold_issue(RB, w_gate, DFF, g2, mod, 3 * DM, 4 * DM, it2, lane), fold_issue(RB, w_up, DFF, g2, mod, 3 * DM, 4 * DM, it2 - I_G, lane), fold_issue(RB, w_in, INC, g1, mod, 0, DM, it2 - 2 * I_G, lane))
        FOLD_DISPATCH(it, fold_finish(RA, DFF, 2 * DFF, Wgu_b, cgu, 1, scr, it, lane), fold_finish(RA, DFF, 2 * DFF, Wgu_b, cgu, 2, scr, it - I_G, lane), fold_finish(RA, INC, INC, Win_b, c1, 0, scr, it - 2 * I_G, lane))
        if (two) FOLD_DISPATCH(it2, fold_finish(RB, DFF, 2 * DFF, Wgu_b, cgu, 1, scr, it2, lane), fold_finish(RB, DFF, 2 * DFF, Wgu_b, cgu, 2, scr, it2 - I_G, lane), fold_finish(RB, INC, INC, Win_b, c1, 0, scr, it2 - 2 * I_G, lane))
    }
}
#undef FOLD_DISPATCH
__device__ __forceinline__ void p_xb(const float* x, bf16* xb, float* rstd1, const int wv) {
    const int wave = wv, lane = lane_fresh();
    const int stride = gridDim.x * 8;
    int row = blockIdx.x * 8 + wave;
    f32x4 v[4], nv[4], nv2[4];
    if (row < NTOK) { const f32x4* xr = (const f32x4*)(x + (size_t)row * DM) + lane;
#pragma unroll
        for (int j = 0; j < 4; ++j) v[j] = __builtin_nontemporal_load(xr + 64 * j); }
    if (row + stride < NTOK) { const f32x4* xr = (const f32x4*)(x + (size_t)(row + stride) * DM) + lane;
#pragma unroll
        for (int j = 0; j < 4; ++j) nv[j] = __builtin_nontemporal_load(xr + 64 * j); }
    for (; row < NTOK; row += stride) {
        if (row + 2 * stride < NTOK) { const f32x4* xr = (const f32x4*)(x + (size_t)(row + 2 * stride) * DM) + lane;
#pragma unroll
            for (int j = 0; j < 4; ++j) nv2[j] = __builtin_nontemporal_load(xr + 64 * j); }
        float s = 0.f;
#pragma unroll
        for (int j = 0; j < 4; ++j) s += (v[j].x * v[j].x + v[j].y * v[j].y) + (v[j].z * v[j].z + v[j].w * v[j].w);
        s = wave_sum(s);
        if (lane == 0) rstd1[row] = 1.0f / sqrtf(s * (1.f / DM) + NORM_EPS);
        unsigned long long* o8 = (unsigned long long*)(xb + (size_t)row * DM) + lane;
#pragma unroll
        for (int j = 0; j < 4; ++j) o8[64 * j] = (unsigned long long)pk2(v[j].x, v[j].y) | ((unsigned long long)pk2(v[j].z, v[j].w) << 32);
#pragma unroll
        for (int j = 0; j < 4; ++j) { v[j] = nv[j]; nv[j] = nv2[j]; }
    }
}

typedef short bf16x8 __attribute__((ext_vector_type(8)));
constexpr int LDA_ = 72;
constexpr int ARR = 64 * LDA_ * 2;
constexpr int O_NAT_A = 0, O_NAT_R = ARR, O_NAT_B = 2 * ARR, O_NAT_K = 3 * ARR, O_TR_A = 4 * ARR, O_TR_BH = 5 * ARR, O_TR_KH = 6 * ARR, O_TR_V = 7 * ARR;
constexpr int AABF_LD = 68;
constexpr int O_AABF = 8 * ARR, O_WT = O_AABF;
constexpr int O_AAK = O_AABF + 64 * AABF_LD * 4, O_U0T = O_NAT_K;
constexpr int O_ARB = O_AAK + ARR, O_ARK = O_ARB + ARR, O_TM = O_ARK + ARR, O_PT = O_TM + ARR;
constexpr int O_WSUM = O_PT + ARR, O_EGC = O_WSUM + 2048, O_RN = O_EGC + 256, O_PARX = O_RN + 256  , O_PAR = O_PARX + 512  , O_CHUNK_END = O_PAR + 8 * 2048;
static_assert(O_CHUNK_END <= 163840 - 1024, "chunk LDS map");

__device__ __forceinline__ f32x4 mm_tile(const LAS unsigned char* X, const LAS unsigned char* Y, int xa, int yb, int fr, int fq, f32x4 acc) {
#pragma unroll
    for (int ks = 0; ks < 2; ++ks) {
        const bf16x8 xf = *(const LAS bf16x8*)(X + ((xa + fr) * LDA_ + ks * 32 + fq * 8) * 2);
        const bf16x8 yf = *(const LAS bf16x8*)(Y + ((yb + fr) * LDA_ + ks * 32 + fq * 8) * 2);
        acc = __builtin_amdgcn_mfma_f32_16x16x32_bf16(xf, yf, acc, 0, 0, 0);
    }
    return acc;
}
__device__ __forceinline__ void st_tile_bf16(LAS unsigned char* Z, int xa, int yb, int fr, int fq, f32x4 acc) {
    u32x2 w; w.x = pk2(acc[0], acc[1]); w.y = pk2(acc[2], acc[3]);
    *(LAS u32x2*)(Z + ((yb + fr) * LDA_ + xa + 4 * fq) * 2) = w;
}
__device__ __forceinline__ float fexp(float x) { return __builtin_amdgcn_exp2f(x * 1.4426950408889634f); }
__device__ __forceinline__ float fsigmoid(float x) { return __builtin_amdgcn_rcpf(1.0f + fexp(-x)); }
__device__ __forceinline__ float ftanh(float x) { return 1.0f - 2.0f * __builtin_amdgcn_rcpf(1.0f + fexp(2.0f * x)); }
__device__ __forceinline__ float fsoftplus(float x) { return fmaxf(x, 0.f) + 0.6931471805599453f * __builtin_amdgcn_logf(1.0f + fexp(-fabsf(x))); }
template <int CTRL> __device__ __forceinline__ float dpp_mov(float v) { return __builtin_bit_cast(float, __builtin_amdgcn_update_dpp(0, __builtin_bit_cast(int, v), CTRL, 0xf, 0xf, true)); }
__device__ __forceinline__ float sum8(float v) { v += dpp_mov<0xB1>(v); v += dpp_mov<0x4E>(v); v += dpp_mov<0x141>(v); return v; }
__device__ __forceinline__ float bflo(unsigned u) { return __builtin_bit_cast(float, u << 16); }
__device__ __forceinline__ float bfhi(unsigned u) { return __builtin_bit_cast(float, u & 0xffff0000u); }
struct ChunkBufs { unsigned char *DG, *YI, *MQ, *H0; float* BON; const bf16 *WLT, *ALT, *GLT, *PRE; };

__device__ __forceinline__ void p_pre(const Params& P, const bf16* proj, bf16* PRE, const int wv) {
    const int lane = lane_fresh(), c0 = (lane & 31) * 8;
    const f32x4 m0 = *(const f32x4*)(P.rwkv_mu + 1536 + c0), m1 = *(const f32x4*)(P.rwkv_mu + 1536 + c0 + 4);
    const bool own = gridDim.x == 256;
    const int stride = own ? 8 : gridDim.x * 8;
    for (int rp0 = own ? 64 * (int)blockIdx.x + wv : (int)blockIdx.x * 8 + wv; rp0 < (own ? 64 * ((int)blockIdx.x + 1) : NTOK / 2); rp0 += 8 * stride) {
        u32x4 cu[8], prv[8];
#pragma unroll
        for (int i = 0; i < 8; ++i) { const int rp = rp0 + i * stride;
            if (rp < NTOK / 2) { const int row = rp * 2 + (lane >> 5); const bool first = (row & (SEQ - 1)) == 0;
                cu[i] = *(const u32x4*)(proj + (size_t)row * INC + 1536 + c0); prv[i] = *(const u32x4*)(proj + (size_t)(first ? row : row - 1) * INC + 1536 + c0); } }
#pragma unroll
        for (int i = 0; i < 8; ++i) { const int rp = rp0 + i * stride;
            if (rp < NTOK / 2) { const int row = rp * 2 + (lane >> 5); const bool first = (row & (SEQ - 1)) == 0;
                float v[8];
#pragma unroll
                for (int e = 0; e < 4; ++e) { const float c_lo = bflo(cu[i][e]), c_hi = bfhi(cu[i][e]), p_lo = first ? 0.f : bflo(prv[i][e]), p_hi = first ? 0.f : bfhi(prv[i][e]);
                    const float mlo = (e < 2) ? m0[2 * e] : m1[2 * e - 4], mhi = (e < 2) ? m0[2 * e + 1] : m1[2 * e - 3];
                    v[2 * e] = c_lo + (p_lo - c_lo) * mlo; v[2 * e + 1] = c_hi + (p_hi - c_hi) * mhi; }
                if (c0 < 64) {
#pragma unroll
                    for (int e = 0; e < 8; ++e) v[e] = ftanh(v[e]); }
                else if (c0 >= 128) {
#pragma unroll
                    for (int e = 0; e < 8; ++e) v[e] = fsigmoid(v[e]); }
                u32x4 o; o.x = pk2(v[0], v[1]); o.y = pk2(v[2], v[3]); o.z = pk2(v[4], v[5]); o.w = pk2(v[6], v[7]);
                *(u32x4*)(PRE + (size_t)row * 256 + c0) = o; } }
    }
}
struct RawLd { u32x4 xw, xa, k_c, k_p, r_c, r_p, v_c, v_p; bf16x8 wf0, wf1; };
__device__ __forceinline__ void chunk_issue(RawLd& R, const bf16* proj, const ChunkBufs& CB, int unit, int tid) {
    const int ch = unit & 127, h = (unit >> 7) & 7, b = unit >> 10, t = tid >> 3, kc = (tid & 7) * 8;
    const size_t row = (size_t)b * SEQ + ch * 64 + t, prow = (ch == 0 && t == 0) ? row : row - 1;
    const bf16* pc = proj + row * INC; const bf16* pp = proj + prow * INC;
    R.xw = *(const u32x4*)(CB.PRE + row * 256 + kc); R.xa = *(const u32x4*)(CB.PRE + row * 256 + 64 + kc);
    R.k_c = *(const u32x4*)(pc + 512 + h * 64 + kc); R.k_p = *(const u32x4*)(pp + 512 + h * 64 + kc);
    R.r_c = *(const u32x4*)(pc + h * 64 + kc); R.r_p = *(const u32x4*)(pp + h * 64 + kc); R.v_c = *(const u32x4*)(pc + 1024 + h * 64 + kc); R.v_p = *(const u32x4*)(pp + 1024 + h * 64 + kc);
    { const int wave = tid >> 6, lane = tid & 63; const bf16* Wt = ((wave >> 2) ? CB.ALT : CB.WLT) + (size_t)(h * 64 + (wave & 3) * 16 + (lane & 15)) * 64 + (lane >> 4) * 8; R.wf0 = *(const bf16x8*)(Wt); R.wf1 = *(const bf16x8*)(Wt + 32); }
}
__device__ __forceinline__ void p_chunkA(const Params& P, const bf16* proj, const ChunkBufs& CB, unsigned char* lds_, const int wv) {
    LAS unsigned char* L = (LAS unsigned char*)lds_;
    const int tid_ = wv * 64 + lane_fresh();
    const int tid = tid_, wave = wv, lane = tid & 63, fr = lane & 15, fq = lane >> 4;
    LAS float* wsum = (LAS float*)(L + O_WSUM);
    LAS float* egc = (LAS float*)(L + O_EGC);
    constexpr int O_XW = O_PT, O_XA = O_TM, O_ZW = O_AABF, O_ZA = O_AAK, ZLD = 68, O_PB = O_ARK;
    constexpr int O_AABH = O_PT, O_TMT = O_NAT_A, O_ZT1 = O_NAT_B, O_ZT2 = O_NAT_K;
    constexpr int RLD = 72, O_RAWR = O_NAT_A, O_RAWK = O_NAT_B, O_RAWV = O_TR_A, O_RAWX = O_PARX;
    static_assert(3 * RLD * 2 <= 512, "predecessor rows fit the parameter slot");
    RawLd cur, nxt;
    {
        LAS float* par = (LAS float*)(L + O_PAR); const int c = tid_;
        par[0 * 512 + c] = P.rwkv_mu[c]; par[1 * 512 + c] = P.rwkv_mu[512 + c]; par[2 * 512 + c] = P.rwkv_mu[1024 + c]; par[3 * 512 + c] = P.r_k[c];
        par[4 * 512 + c] = P.w0[c]; par[5 * 512 + c] = P.a0[c]; par[6 * 512 + c] = P.k_k[c]; par[7 * 512 + c] = P.k_a[c];
    }
    const bool own = gridDim.x == 256;
    const int nun = own ? 16 : ((BATCH * 8 * 128 - (int)blockIdx.x + (int)gridDim.x - 1) / (int)gridDim.x);
#define UNIT_OF(k_) (own ? (((2 * (int)blockIdx.x + ((k_) >> 3)) >> 7) * 8 + ((k_) & 7)) * 128 + ((2 * (int)blockIdx.x + ((k_) >> 3)) & 127) : (int)blockIdx.x + (k_) * (int)gridDim.x)
    if (nun > 0) chunk_issue(cur, proj, CB, UNIT_OF(0), tid);
    __syncthreads();
    for (int uk = 0; uk < nun; ++uk) {
        const int unit = UNIT_OF(uk);
        const int ch = unit & 127, h = (unit >> 7) & 7, b = unit >> 10;
        const size_t rowbase = (size_t)b * SEQ + ch * 64;
        const int tidl_ = wv * 64 + lane_fresh();
        const int tid = tidl_, lane = tid & 63, fr = lane & 15, fq = lane >> 4;
        unsigned char* const uDG = CB.DG + (size_t)unit * 8192; unsigned char* const uYI = CB.YI + (size_t)unit * 8192; unsigned char* const uMQ = CB.MQ + (size_t)unit * 16384;
        {
            const int t = tid >> 3, kc = (tid & 7) * 8;
            const bool first = (ch == 0 && t == 0);
            const u32x4 zero4 = (u32x4){0u, 0u, 0u, 0u};
            const u32x4 k_p = first ? zero4 : cur.k_p, r_p = first ? zero4 : cur.r_p, v_p = first ? zero4 : cur.v_p;
            *(LAS u32x4*)(L + O_XW + (t * LDA_ + kc) * 2) = cur.xw; *(LAS u32x4*)(L + O_XA + (t * LDA_ + kc) * 2) = cur.xa;
            {
                const int c0 = 512 + h * 64 + kc;
                const f32x4 m0 = *(const LAS f32x4*)(L + O_PAR + (1 * 512 + h * 64 + kc) * 4), m1 = *(const LAS f32x4*)(L + O_PAR + (1 * 512 + h * 64 + kc + 4) * 4), q0 = *(const LAS f32x4*)(L + O_PAR + (6 * 512 + h * 64 + kc) * 4), q1 = *(const LAS f32x4*)(L + O_PAR + (6 * 512 + h * 64 + kc + 4) * 4);
                float ss = 0.f;
#pragma unroll
                for (int e = 0; e < 4; ++e) { const float c_lo = bflo(cur.k_c[e]), c_hi = bfhi(cur.k_c[e]), p_lo = bflo(k_p[e]), p_hi = bfhi(k_p[e]);
                    const float mlo = (e < 2) ? m0[2 * e] : m1[2 * e - 4], mhi = (e < 2) ? m0[2 * e + 1] : m1[2 * e - 3], klo = (e < 2) ? q0[2 * e] : q1[2 * e - 4], khi = (e < 2) ? q0[2 * e + 1] : q1[2 * e - 3];
                    const float a = (c_lo + (p_lo - c_lo) * mlo) * klo, bq = (c_hi + (p_hi - c_hi) * mhi) * khi; ss += a * a + bq * bq; }
                ss = sum8(ss);
                if ((tid & 7) == 0) *(LAS float*)(L + O_RN + t * 4) = 1.0f / fmaxf(sqrtf(ss), 1e-12f);
            }
            *(LAS u32x4*)(L + O_RAWR + (t * RLD + kc) * 2) = cur.r_c; *(LAS u32x4*)(L + O_RAWK + (t * RLD + kc) * 2) = cur.k_c; *(LAS u32x4*)(L + O_RAWV + (t * RLD + kc) * 2) = cur.v_c;
            if (t == 0) { *(LAS u32x4*)(L + O_RAWX + kc * 2) = r_p; *(LAS u32x4*)(L + O_RAWX + (RLD + kc) * 2) = k_p; *(LAS u32x4*)(L + O_RAWX + (2 * RLD + kc) * 2) = v_p; }
        }
        const int j = lane, tg = wave, col = h * 64 + j;
        const size_t row0 = rowbase + tg * 8;
        __syncthreads();
        {
            const int which = wave >> 2, ct = wave & 3;
            const bf16x8 wf0 = cur.wf0, wf1 = cur.wf1;
            const LAS unsigned char* X = L + (which ? O_XA : O_XW);
#pragma unroll
            for (int tt = 0; tt < 4; ++tt) {
                f32x4 acc = (f32x4){0.f, 0.f, 0.f, 0.f};
                const bf16x8 x0 = *(const LAS bf16x8*)(X + ((tt * 16 + fr) * LDA_ + fq * 8) * 2), x1 = *(const LAS bf16x8*)(X + ((tt * 16 + fr) * LDA_ + 32 + fq * 8) * 2);
                acc = __builtin_amdgcn_mfma_f32_16x16x32_bf16(x0, wf0, acc, 0, 0, 0);
                acc = __builtin_amdgcn_mfma_f32_16x16x32_bf16(x1, wf1, acc, 0, 0, 0);
                *(LAS f32x4*)(L + (which ? O_ZA : O_ZW) + ((ct * 16 + fr) * ZLD + tt * 16 + 4 * fq) * 4) = acc;
            }
        }
        __syncthreads();
        if (uk + 1 < nun) chunk_issue(nxt, proj, CB, UNIT_OF(uk + 1), tid);
        {
            float lw[8], kp[8], kk[8], bb[8], r[8], v[8];
            float pr_[9], pk_[9], pv_[9];
#pragma unroll
            for (int q = 1; q < 9; ++q) { pr_[q] = bf2f(*(const LAS unsigned short*)(L + O_RAWR + ((tg * 8 + q - 1) * RLD + j) * 2)); pk_[q] = bf2f(*(const LAS unsigned short*)(L + O_RAWK + ((tg * 8 + q - 1) * RLD + j) * 2)); pv_[q] = bf2f(*(const LAS unsigned short*)(L + O_RAWV + ((tg * 8 + q - 1) * RLD + j) * 2)); }
            {
                const int oR0 = (tg == 0) ? O_RAWX : O_RAWR + (tg * 8 - 1) * RLD * 2, oK0 = (tg == 0) ? O_RAWX + RLD * 2 : O_RAWK + (tg * 8 - 1) * RLD * 2, oV0 = (tg == 0) ? O_RAWX + 2 * RLD * 2 : O_RAWV + (tg * 8 - 1) * RLD * 2;
                pr_[0] = bf2f(*(const LAS unsigned short*)(L + oR0 + j * 2)); pk_[0] = bf2f(*(const LAS unsigned short*)(L + oK0 + j * 2)); pv_[0] = bf2f(*(const LAS unsigned short*)(L + oV0 + j * 2)); }
            const LAS float* par = (const LAS float*)(L + O_PAR) + col;
            const float mur = par[0], muk = par[512], muv = par[1024], rk = par[1536], w0 = par[2048], a0 = par[2560], kkc = par[3072], kac = par[3584];
            const float nw0 = -1.4426950408889634f * w0, na0 = -1.4426950408889634f * a0, kc1 = 1.0f - kac;
            const f32x4 rn0 = *(const LAS f32x4*)(L + O_RN + (tg * 8) * 4), rn1 = *(const LAS f32x4*)(L + O_RN + (tg * 8 + 4) * 4);
            const f32x4 zw0 = *(const LAS f32x4*)(L + O_ZW + (j * ZLD + tg * 8) * 4), zw1 = *(const LAS f32x4*)(L + O_ZW + (j * ZLD + tg * 8 + 4) * 4);
            const f32x4 za0 = *(const LAS f32x4*)(L + O_ZA + (j * ZLD + tg * 8) * 4), za1 = *(const LAS f32x4*)(L + O_ZA + (j * ZLD + tg * 8 + 4) * 4);
#pragma unroll
            for (int tt = 0; tt < 8; ++tt) {
                const float zw = (tt < 4) ? zw0[tt & 3] : zw1[tt & 3], za = (tt < 4) ? za0[tt & 3] : za1[tt & 3];
                r[tt] = pr_[tt + 1] + (pr_[tt] - pr_[tt + 1]) * mur; v[tt] = pv_[tt + 1] + (pv_[tt] - pv_[tt + 1]) * muv;
                const float k = pk_[tt + 1] + (pk_[tt] - pk_[tt + 1]) * muk;
                lw[tt] = -0.8750387749145276f * __builtin_amdgcn_rcpf(1.0f + __builtin_amdgcn_exp2f(__builtin_fmaf(zw, -1.4426950408889634f, nw0)));
                const float a = __builtin_amdgcn_rcpf(1.0f + __builtin_amdgcn_exp2f(__builtin_fmaf(za, -1.4426950408889634f, na0)));
                kk[tt] = k * kkc * ((tt < 4) ? rn0[tt & 3] : rn1[tt & 3]);
                kp[tt] = k * __builtin_fmaf(a, kac, kc1);
                bb[tt] = kk[tt] * a;
                *(LAS float*)(L + O_PB + ((tg * 8 + tt) * ZLD + j) * 4) = r[tt] * kp[tt] * rk;
            }
            float gl[8]; float s = 0.f;
#pragma unroll
            for (int tt = 0; tt < 8; ++tt) { s += lw[tt]; gl[tt] = s; }
            wsum[tg * 64 + j] = s;
            __syncthreads();
            { const int t = tid >> 3, kc = (tid & 7) * 8;
              const f32x4 b0 = *(const LAS f32x4*)(L + O_PB + (t * ZLD + kc) * 4), b1 = *(const LAS f32x4*)(L + O_PB + (t * ZLD + kc + 4) * 4);
              const float bs = sum8(((b0[0] + b0[1]) + (b0[2] + b0[3])) + ((b1[0] + b1[1]) + (b1[2] + b1[3])));
              if ((tid & 7) == 0) CB.BON[(rowbase + t) * 8 + h] = bs; }
            float off = 0.f, tot = 0.f;
#pragma unroll
            for (int g = 0; g < 8; ++g) { const float ws = wsum[g * 64 + j]; tot += ws; if (g < tg) off += ws; }
            const float etot = __builtin_amdgcn_exp2f(tot);
            if (tg == 0) egc[j] = etot;
            u32x4 tA, tBH, tKH, tV;
            float e_prev = __builtin_amdgcn_exp2f(off);
#pragma unroll
            for (int tp = 0; tp < 4; ++tp) {
                float At[2], Rt[2], Bt[2], Kt[2], Bh[2], Kh[2];
#pragma unroll
                for (int u = 0; u < 2; ++u) { const int tt = 2 * tp + u;
                    const float e_i = __builtin_amdgcn_exp2f(off + gl[tt]), e_n = __builtin_amdgcn_rcpf(e_i);
                    At[u] = -kk[tt] * e_prev; Rt[u] = r[tt] * e_i; Bt[u] = bb[tt] * e_n; Kt[u] = kp[tt] * e_n; Bh[u] = Bt[u] * etot; Kh[u] = Kt[u] * etot; e_prev = e_i; }
                const unsigned pa = pk2(At[0], At[1]), pr = pk2(Rt[0], Rt[1]), pb = pk2(Bt[0], Bt[1]), pk_ = pk2(Kt[0], Kt[1]);
                const int t0 = tg * 8 + 2 * tp;
                *(LAS unsigned short*)(L + O_NAT_A + (t0 * LDA_ + j) * 2) = (unsigned short)pa; *(LAS unsigned short*)(L + O_NAT_A + ((t0 + 1) * LDA_ + j) * 2) = (unsigned short)(pa >> 16);
                *(LAS unsigned short*)(L + O_NAT_R + (t0 * LDA_ + j) * 2) = (unsigned short)pr; *(LAS unsigned short*)(L + O_NAT_R + ((t0 + 1) * LDA_ + j) * 2) = (unsigned short)(pr >> 16);
                *(LAS unsigned short*)(L + O_NAT_B + (t0 * LDA_ + j) * 2) = (unsigned short)pb; *(LAS unsigned short*)(L + O_NAT_B + ((t0 + 1) * LDA_ + j) * 2) = (unsigned short)(pb >> 16);
                *(LAS unsigned short*)(L + O_NAT_K + (t0 * LDA_ + j) * 2) = (unsigned short)pk_; *(LAS unsigned short*)(L + O_NAT_K + ((t0 + 1) * LDA_ + j) * 2) = (unsigned short)(pk_ >> 16);
                tA[tp] = pa; tBH[tp] = pk2(Bh[0], Bh[1]); tKH[tp] = pk2(Kh[0], Kh[1]); tV[tp] = pk2(v[2 * tp], v[2 * tp + 1]);
            }
            *(LAS u32x4*)(L + O_TR_A + (j * LDA_ + tg * 8) * 2) = tA;
            *(LAS u32x4*)(L + O_TR_BH + (j * LDA_ + tg * 8) * 2) = tBH;
            *(LAS u32x4*)(L + O_TR_KH + (j * LDA_ + tg * 8) * 2) = tKH;
            *(LAS u32x4*)(L + O_TR_V + (j * LDA_ + tg * 8) * 2) = tV;
        }
        __syncthreads();
#define FRAG(arr, row, ks) (*(const LAS bf16x8*)(lbase + (unsigned)((arr) + (row) * (LDA_ * 2) + (ks) * 64)))
        unsigned lbase = (unsigned)(uintptr_t)L + (unsigned)((fr * LDA_ + fq * 8) * 2); asm volatile("" : "+v"(lbase));
#define MM2(x0, x1, y0, y1, c) __builtin_amdgcn_mfma_f32_16x16x32_bf16(x1, y1, __builtin_amdgcn_mfma_f32_16x16x32_bf16(x0, y0, c, 0, 0, 0), 0, 0, 0)
        const f32x4 zacc = (f32x4){0.f, 0.f, 0.f, 0.f};
        if (wave == 0) {
            {
                bf16x8 xb_[4][2], ya_[4][2];
#pragma unroll
                for (int I = 0; I < 4; ++I)
#pragma unroll
                    for (int ks = 0; ks < 2; ++ks) { xb_[I][ks] = FRAG(O_NAT_B, I * 16, ks); ya_[I][ks] = FRAG(O_NAT_A, I * 16, ks); }
#pragma unroll
                for (int I = 0; I < 4; ++I) { f32x4 d_ = MM2(xb_[I][0], xb_[I][1], ya_[I][0], ya_[I][1], zacc);
#pragma unroll
                    for (int r = 0; r < 4; ++r) d_[r] = (4 * fq + r < fr) ? d_[r] : 0.f;
                    *(LAS f32x4*)(L + O_AABF + ((I * 16 + fr) * AABF_LD + I * 16 + 4 * fq) * 4) = d_; }
            }
            LDS_WAIT();
            const int blk = lane >> 4, c = lane & 15;
            const LAS float* A = (const LAS float*)(L + O_AABF) + (16 * blk) * AABF_LD + 16 * blk;
            f32x4 ar[16][4];
#pragma unroll
            for (int r = 1; r < 16; ++r)
#pragma unroll
                for (int k = 0; k < 4; ++k) if (4 * k < r) ar[r][k] = *(const LAS f32x4*)(A + r * AABF_LD + 4 * k);
            float x[16];
            x[0] = (c == 0) ? 1.f : 0.f;
#pragma unroll
            for (int r = 1; r < 16; ++r) {
                float a0 = (r == c) ? 1.f : 0.f, a1 = 0.f;
#pragma unroll
                for (int q = 0; q < r; ++q) { if (q & 1) a1 += ar[r][q >> 2][q & 3] * x[q]; else a0 += ar[r][q >> 2][q & 3] * x[q]; }
                x[r] = a0 + a1;
            }
#pragma unroll
            for (int r = 0; r < 16; r += 2) { const unsigned pr = pk2(x[r], x[r + 1]);
                *(LAS unsigned short*)(L + O_TM + ((16 * blk + r) * LDA_ + 16 * blk + c) * 2) = (unsigned short)(pr & 0xffffu); *(LAS unsigned short*)(L + O_TM + ((16 * blk + r + 1) * LDA_ + 16 * blk + c) * 2) = (unsigned short)(pr >> 16); }
        } else if (wave != 4) {
            const int v_ = (wave < 4) ? wave - 1 : wave - 2, p = 1 + (v_ >> 1), o = v_ & 1;
            const int oX = (p & 1) ? O_NAT_K : O_NAT_B, oY = (p >> 1) ? O_NAT_R : O_NAT_A;
            const int tA = o, tB = 3 - o, s1 = o ? 1 : 3;
            bf16x8 xf[4][2], yf[2][2];
#pragma unroll
            for (int ks = 0; ks < 2; ++ks) { xf[0][ks] = FRAG(oX, 0, ks); xf[1][ks] = FRAG(oX, 16, ks); xf[2][ks] = FRAG(oX, 32, ks); xf[3][ks] = FRAG(oX, s1 * 16, ks); yf[0][ks] = FRAG(oY, tA * 16, ks); yf[1][ks] = FRAG(oY, tB * 16, ks); }
            f32x4 acc[5]; int tts[5], sts[5];
            acc[0] = MM2(xf[0][0], xf[0][1], yf[0][0], yf[0][1], zacc); tts[0] = tA; sts[0] = 0;
            acc[1] = o ? MM2(xf[3][0], xf[3][1], yf[0][0], yf[0][1], zacc) : MM2(xf[3][0], xf[3][1], yf[1][0], yf[1][1], zacc); tts[1] = o ? tA : tB; sts[1] = s1;
            acc[2] = MM2(xf[0][0], xf[0][1], yf[1][0], yf[1][1], zacc); tts[2] = tB; sts[2] = 0;
            acc[3] = MM2(xf[1][0], xf[1][1], yf[1][0], yf[1][1], zacc); tts[3] = tB; sts[3] = 1;
            acc[4] = MM2(xf[2][0], xf[2][1], yf[1][0], yf[1][1], zacc); tts[4] = tB; sts[4] = 2;
            const int oZ = (p == 1) ? O_AAK : ((p == 2) ? O_ARB : O_ARK);
#pragma unroll
            for (int k = 0; k < 5; ++k) {
                const int t = tts[k] * 16 + fr, s0 = sts[k] * 16 + 4 * fq;
#pragma unroll
                for (int r = 0; r < 4; ++r) { const bool keep = (p < 2) ? (s0 + r < t) : (s0 + r <= t); acc[k][r] = keep ? acc[k][r] : 0.f; }
                st_tile_bf16(L + oZ, sts[k] * 16, tts[k] * 16, fr, fq, acc[k]);
            }
            st_tile_bf16(L + oZ, (o ? 2 : 1) * 16, (o ? 1 : 0) * 16, fr, fq, zacc); st_tile_bf16(L + oZ, (o ? 3 : 2) * 16, (o ? 1 : 0) * 16, fr, fq, zacc); st_tile_bf16(L + oZ, 3 * 16, (o ? 2 : 0) * 16, fr, fq, zacc);
        } else {
            bf16x8 xf[3][2], yf[3][2];
#pragma unroll
            for (int ks = 0; ks < 2; ++ks)
#pragma unroll
                for (int q = 0; q < 3; ++q) { xf[q][ks] = FRAG(O_NAT_B, q * 16, ks); yf[q][ks] = FRAG(O_NAT_A, (q + 1) * 16, ks); }
            f32x4 acc[6];
            acc[0] = MM2(xf[0][0], xf[0][1], yf[0][0], yf[0][1], zacc);
            acc[1] = MM2(xf[0][0], xf[0][1], yf[1][0], yf[1][1], zacc); acc[2] = MM2(xf[1][0], xf[1][1], yf[1][0], yf[1][1], zacc);
            acc[3] = MM2(xf[0][0], xf[0][1], yf[2][0], yf[2][1], zacc); acc[4] = MM2(xf[1][0], xf[1][1], yf[2][0], yf[2][1], zacc); acc[5] = MM2(xf[2][0], xf[2][1], yf[2][0], yf[2][1], zacc);
            st_tile_bf16(L + O_AABH, 0, 16, fr, fq, acc[0]);
            st_tile_bf16(L + O_AABH, 0, 32, fr, fq, acc[1]); st_tile_bf16(L + O_AABH, 16, 32, fr, fq, acc[2]);
            st_tile_bf16(L + O_AABH, 0, 48, fr, fq, acc[3]); st_tile_bf16(L + O_AABH, 16, 48, fr, fq, acc[4]); st_tile_bf16(L + O_AABH, 32, 48, fr, fq, acc[5]);
        }
        __syncthreads();
        asm volatile("" : "+v"(lbase));
        {
            const int isU = wave >> 2, ct = wave & 3;
            const int oXo = isU ? O_U0T : O_WT;
            u32x2 tii[4], ab[6]; f32x4 R_[4];
#pragma unroll
            for (int I = 0; I < 4; ++I) tii[I] = *(const LAS u32x2*)(L + O_TM + ((16 * I + fr) * LDA_ + 16 * I + 4 * fq) * 2);
            if (isU) {
                bf16x8 vf[2], af[4][2];
#pragma unroll
                for (int ks = 0; ks < 2; ++ks) { vf[ks] = FRAG(O_TR_V, ct * 16, ks);
#pragma unroll
                    for (int I = 0; I < 4; ++I) af[I][ks] = FRAG(O_AAK, I * 16, ks); }
#pragma unroll
                for (int I = 0; I < 4; ++I) R_[I] = MM2(af[I][0], af[I][1], vf[0], vf[1], zacc);
            } else {
#pragma unroll
                for (int I = 0; I < 4; ++I) { const u32x2 q_ = *(const LAS u32x2*)(L + O_TR_A + ((16 * ct + fr) * LDA_ + 16 * I + 4 * fq) * 2); R_[I] = (f32x4){bflo(q_.x), bfhi(q_.x), bflo(q_.y), bfhi(q_.y)}; }
            }
#define AB_(I, J) (*(const LAS u32x2*)(L + O_AABH + ((16 * (I) + fr) * LDA_ + 16 * (J) + 4 * fq) * 2))
            ab[0] = AB_(1, 0); ab[1] = AB_(2, 0); ab[2] = AB_(2, 1); ab[3] = AB_(3, 0); ab[4] = AB_(3, 1); ab[5] = AB_(3, 2);
#undef AB_
            const u32x2 z2 = (u32x2){0u, 0u};
#define MK8(lo, hi) __builtin_bit_cast(bf16x8, (u32x4){(lo).x, (lo).y, (hi).x, (hi).y})
#define UNP(q) (f32x4){bflo((q).x), bfhi((q).x), bflo((q).y), bfhi((q).y)}
#define PKA(a_) (u32x2){pk2((a_)[0], (a_)[1]), pk2((a_)[2], (a_)[3])}
            f32x4 X0, X1, X2, X3, a_;
            a_ = R_[0];
            { const u32x2 p = PKA(a_); X0 = __builtin_amdgcn_mfma_f32_16x16x32_bf16(MK8(tii[0], z2), MK8(p, z2), zacc, 0, 0, 0); }
            const u32x2 x0p = PKA(X0);
            a_ = __builtin_amdgcn_mfma_f32_16x16x32_bf16(MK8(ab[0], z2), MK8(x0p, z2), R_[1], 0, 0, 0);
            { const u32x2 p = PKA(a_); X1 = __builtin_amdgcn_mfma_f32_16x16x32_bf16(MK8(tii[1], z2), MK8(p, z2), zacc, 0, 0, 0); }
            const u32x2 x1p = PKA(X1);
            a_ = __builtin_amdgcn_mfma_f32_16x16x32_bf16(MK8(ab[1], ab[2]), MK8(x0p, x1p), R_[2], 0, 0, 0);
            { const u32x2 p = PKA(a_); X2 = __builtin_amdgcn_mfma_f32_16x16x32_bf16(MK8(tii[2], z2), MK8(p, z2), zacc, 0, 0, 0); }
            const u32x2 x2p = PKA(X2);
            a_ = __builtin_amdgcn_mfma_f32_16x16x32_bf16(MK8(ab[3], ab[4]), MK8(x0p, x1p), R_[3], 0, 0, 0);
            a_ = __builtin_amdgcn_mfma_f32_16x16x32_bf16(MK8(ab[5], z2), MK8(x2p, z2), a_, 0, 0, 0);
            { const u32x2 p = PKA(a_); X3 = __builtin_amdgcn_mfma_f32_16x16x32_bf16(MK8(tii[3], z2), MK8(p, z2), zacc, 0, 0, 0); }
#undef MK8
#undef UNP
#undef PKA
            st_tile_bf16(L + oXo, 0, 16 * ct, fr, fq, X0); st_tile_bf16(L + oXo, 16, 16 * ct, fr, fq, X1); st_tile_bf16(L + oXo, 32, 16 * ct, fr, fq, X2); st_tile_bf16(L + oXo, 48, 16 * ct, fr, fq, X3);
        }
        __syncthreads();
        asm volatile("" : "+v"(lbase));
        {
            const int xt = wave & 3, y0 = wave >> 2;
            bf16x8 wtf[2], bhf[2][2], arf[2][2];
#pragma unroll
            for (int ks = 0; ks < 2; ++ks) { wtf[ks] = FRAG(O_WT, xt * 16, ks);
#pragma unroll
                for (int q = 0; q < 2; ++q) { bhf[q][ks] = FRAG(O_TR_BH, (y0 + 2 * q) * 16, ks); arf[q][ks] = FRAG(O_ARB, (y0 + 2 * q) * 16, ks); } }
            u32x2 rr[2];
#pragma unroll
            for (int q = 0; q < 2; ++q) rr[q] = *(const LAS u32x2*)(L + O_NAT_R + (((y0 + 2 * q) * 16 + fr) * LDA_ + xt * 16 + 4 * fq) * 2);
            float eg[2];
#pragma unroll
            for (int q = 0; q < 2; ++q) eg[q] = egc[(y0 + 2 * q) * 16 + fr];
            f32x4 am[2], aq[2];
#pragma unroll
            for (int q = 0; q < 2; ++q) { am[q] = MM2(wtf[0], wtf[1], bhf[q][0], bhf[q][1], zacc); aq[q] = MM2(wtf[0], wtf[1], arf[q][0], arf[q][1], zacc); }
#pragma unroll
            for (int q = 0; q < 2; ++q) {
                const int yt = y0 + 2 * q, yi = yt * 16 + fr, k0 = xt * 16 + 4 * fq, pos = (32 * (xt >> 1) + 8 * fq + 4 * (xt & 1)) * 2;
#pragma unroll
                for (int r = 0; r < 4; ++r) if (k0 + r == yi) am[q][r] += eg[q];
                u32x2 w; w.x = pk2(am[q][0], am[q][1]); w.y = pk2(am[q][2], am[q][3]);
                *(u32x2*)(uMQ + yi * 128 + pos) = w;
                aq[q][0] += bflo(rr[q].x); aq[q][1] += bfhi(rr[q].x); aq[q][2] += bflo(rr[q].y); aq[q][3] += bfhi(rr[q].y);
                u32x2 v; v.x = pk2(aq[q][0], aq[q][1]); v.y = pk2(aq[q][2], aq[q][3]);
                *(u32x2*)(uMQ + 8192 + yi * 128 + pos) = v;
            }
        }
        asm volatile("" : "+v"(lbase));
        {
            const int xt = wave & 3, y0 = wave >> 2;
            bf16x8 bhx[2], khx[2], u0x[2], vx[2], u0y[2][2], vy[2][2], ary[2][2], aky[2][2];
#pragma unroll
            for (int ks = 0; ks < 2; ++ks) { bhx[ks] = FRAG(O_TR_BH, xt * 16, ks); khx[ks] = FRAG(O_TR_KH, xt * 16, ks); u0x[ks] = FRAG(O_U0T, xt * 16, ks); vx[ks] = FRAG(O_TR_V, xt * 16, ks);
#pragma unroll
                for (int q = 0; q < 2; ++q) { u0y[q][ks] = FRAG(O_U0T, (y0 + 2 * q) * 16, ks); vy[q][ks] = FRAG(O_TR_V, (y0 + 2 * q) * 16, ks); ary[q][ks] = FRAG(O_ARB, (y0 + 2 * q) * 16, ks); aky[q][ks] = FRAG(O_ARK, (y0 + 2 * q) * 16, ks); } }
            f32x4 ad[2], ay[2];
#pragma unroll
            for (int q = 0; q < 2; ++q) { ad[q] = MM2(khx[0], khx[1], vy[q][0], vy[q][1], MM2(bhx[0], bhx[1], u0y[q][0], u0y[q][1], zacc)); ay[q] = MM2(vx[0], vx[1], aky[q][0], aky[q][1], MM2(u0x[0], u0x[1], ary[q][0], ary[q][1], zacc)); }
#pragma unroll
            for (int q = 0; q < 2; ++q) { const int yt = y0 + 2 * q;
                u32x2 wd; wd.x = pk2(ad[q][0], ad[q][1]); wd.y = pk2(ad[q][2], ad[q][3]); *(u32x2*)(uDG + (yt * 4 + xt) * 512 + lane * 8) = wd;
                u32x2 wy; wy.x = pk2(ay[q][0], ay[q][1]); wy.y = pk2(ay[q][2], ay[q][3]); *(u32x2*)(uYI + (yt * 4 + xt) * 512 + lane * 8) = wy; }
        }
#undef FRAG
#undef MM2
        cur = nxt;
    }
}

#undef UNIT_OF
constexpr int SB_NL = 2, SB_Q = 6, SB_DEPTH = 14, SB_SLOT = 10240, SB_FLAGS = SB_DEPTH * SB_SLOT;
static_assert((SB_Q - 1) * SB_NL < SB_DEPTH && SB_Q * 10 <= 63 && SB_DEPTH % SB_NL == 0 && SB_FLAGS + 128 <= 163840, "ring geometry");
__device__ __forceinline__ void glds16(const void* gsrc, unsigned lds_dst) { unsigned keep;
    asm volatile("s_mov_b32 %0, m0\n\ts_mov_b32 m0, %2\n\ts_nop 0\n\tglobal_load_lds_dwordx4 %1, off\n\ts_mov_b32 m0, %0" : "=&s"(keep) : "v"(gsrc), "s"(lds_dst) : "memory"); }
__device__ __forceinline__ void glds16_nt(const void* gsrc, unsigned lds_dst) { unsigned keep;
    asm volatile("s_mov_b32 %0, m0\n\ts_mov_b32 m0, %2\n\ts_nop 0\n\tglobal_load_lds_dwordx4 %1, off nt\n\ts_mov_b32 m0, %0" : "=&s"(keep) : "v"(gsrc), "s"(lds_dst) : "memory"); }
__device__ __forceinline__ void sb_issue(const unsigned char* uMQ, const unsigned char* uDG, int it, int lane, unsigned slot_addr) {
    const int fr = lane & 15, fq = lane >> 4;
#pragma unroll
    for (int jt = 0; jt < 4; ++jt)
#pragma unroll
        for (int ks = 0; ks < 2; ++ks)
            glds16(uMQ + (jt * 16 + fr) * 128 + (32 * ks + 8 * fq) * 2, (unsigned)__builtin_amdgcn_readfirstlane((int)(slot_addr + (jt * 2 + ks) * 1024)));
#pragma unroll
    for (int p = 0; p < 2; ++p)
        glds16_nt(uDG + it * 2048 + p * 1024 + lane * 16, (unsigned)__builtin_amdgcn_readfirstlane((int)(slot_addr + 8192 + p * 1024)));
}
__device__ __forceinline__ unsigned lds_poll(const LAS unsigned* p) { return (unsigned)__builtin_amdgcn_readfirstlane((int)*(const volatile LAS unsigned*)p); }
template <int N> __device__ __forceinline__ void wait_vm() { asm volatile("s_waitcnt vmcnt(%0)" :: "n"(N) : "memory"); }
__device__ __forceinline__ void p_chunkB(const ChunkBufs& CB, unsigned char* lds_, const int wv) {
    LAS unsigned char* L = (LAS unsigned char*)lds_;
    LAS unsigned* flg = (LAS unsigned*)(L + SB_FLAGS);
    for (int item = blockIdx.x; item < 128; item += gridDim.x) {
    __syncthreads();
    if (wv == 0) { const int l0 = lane_fresh(); if (l0 < 32) flg[l0] = 0u; }
    __syncthreads();
    if (wv > SB_NL) continue;
    const int lane = lane_fresh();
    const int pr = (item & 7) + 8 * ((item >> 5) & 3), it = (item >> 3) & 3, h = pr & 7, b = pr >> 3;
    const unsigned lds0 = (unsigned)(uintptr_t)L;
    const size_t u0 = (size_t)(b * 8 + h) * 128;
    if (wv == 0) {
        f32x4 acc[4];
#pragma unroll
        for (int jt = 0; jt < 4; ++jt) acc[jt] = (f32x4){0.f, 0.f, 0.f, 0.f};
        u32x4 mfA[4][2], mfB[4][2]; u32x2 dA[4], dB[4];
#define SB_READ(MF, D, SL) { const LAS unsigned char* S_ = L + (SL) * SB_SLOT; _Pragma("unroll") for (int jt = 0; jt < 4; ++jt) { MF[jt][0] = *(const LAS u32x4*)(S_ + (jt * 2 + 0) * 1024 + lane * 16); MF[jt][1] = *(const LAS u32x4*)(S_ + (jt * 2 + 1) * 1024 + lane * 16); D[jt] = *(const LAS u32x2*)(S_ + 8192 + jt * 512 + lane * 8); } }
        while (lds_poll(flg) != 1u) { }
        asm volatile("" ::: "memory");
        SB_READ(mfA, dA, 0);
        unsigned f = *(const volatile LAS unsigned*)(flg + 1);
        asm volatile("s_waitcnt lgkmcnt(0)" ::: "memory");
        if (lane == 0) flg[16] = 1u;
        int nslot = 1;
        unsigned char* hp = CB.H0 + u0 * 8192 + it * 1024 + lane * 16;
#define SB_STEP(CH, MF, D, MFN, DN) { \
            f32x4 d_[4], a_[4]; \
            _Pragma("unroll") for (int jt = 0; jt < 4; ++jt) { d_[jt][0] = bflo(D[jt].x); d_[jt][1] = bfhi(D[jt].x); d_[jt][2] = bflo(D[jt].y); d_[jt][3] = bfhi(D[jt].y); } \
            u32x4 hb0, hb1; hb0.x = pk2(acc[0][0], acc[0][1]); hb0.y = pk2(acc[0][2], acc[0][3]); hb0.z = pk2(acc[1][0], acc[1][1]); hb0.w = pk2(acc[1][2], acc[1][3]); \
            _Pragma("unroll") for (int jt = 0; jt < 4; ++jt) a_[jt] = __builtin_amdgcn_mfma_f32_16x16x32_bf16(__builtin_bit_cast(bf16x8, MF[jt][0]), __builtin_bit_cast(bf16x8, hb0), d_[jt], 0, 0, 0); \
            __builtin_amdgcn_sched_barrier(0); \
            hb1.x = pk2(acc[2][0], acc[2][1]); hb1.y = pk2(acc[2][2], acc[2][3]); hb1.z = pk2(acc[3][0], acc[3][1]); hb1.w = pk2(acc[3][2], acc[3][3]); \
            __builtin_amdgcn_sched_barrier(0); \
            *(u32x4*)hp = hb0; *(u32x4*)(hp + 4096) = hb1; hp += 8192; \
            if ((CH) + 1 < 128) { \
                unsigned fu = (unsigned)__builtin_amdgcn_readfirstlane((int)f); \
                while (fu != (unsigned)((CH) + 2)) fu = lds_poll(flg + nslot); \
                asm volatile("" ::: "memory"); \
                SB_READ(MFN, DN, nslot); \
                nslot = (nslot == SB_DEPTH - 1) ? 0 : nslot + 1; \
                f = *(const volatile LAS unsigned*)(flg + nslot); \
            } \
            __builtin_amdgcn_sched_barrier(0); \
            _Pragma("unroll") for (int jt = 0; jt < 4; ++jt) acc[jt] = __builtin_amdgcn_mfma_f32_16x16x32_bf16(__builtin_bit_cast(bf16x8, MF[jt][1]), __builtin_bit_cast(bf16x8, hb1), a_[jt], 0, 0, 0); \
            __builtin_amdgcn_sched_barrier(0); \
            if ((CH) + 1 < 128) { asm volatile("s_waitcnt lgkmcnt(0)" ::: "memory"); if (lane == 0) flg[16] = (unsigned)((CH) + 2); }        \
        }
        for (int ch = 0; ch < 128; ch += 2) {
            SB_STEP(ch, mfA, dA, mfB, dB)
            SB_STEP(ch + 1, mfB, dB, mfA, dA)
        }
#undef SB_STEP
#undef SB_READ
    } else {
        const int lw = wv - 1;
        int slot = lw, slot_f = lw, k = 0;
        for (int c = lw; c < 128; c += SB_NL, ++k) {
            if (c >= SB_DEPTH) { const unsigned need = (unsigned)(c - SB_DEPTH + 1); while (lds_poll(flg + 16) < need) __builtin_amdgcn_s_sleep(1); }
            asm volatile("" ::: "memory");
            sb_issue(CB.MQ + (u0 + c) * 16384, CB.DG + (u0 + c) * 8192, it, lane, lds0 + slot * SB_SLOT);
            slot += SB_NL; if (slot >= SB_DEPTH) slot -= SB_DEPTH;
            if (k >= SB_Q - 1) { wait_vm<10 * (SB_Q - 1)>();
                if (lane == 0) flg[slot_f] = (unsigned)(c - (SB_Q - 1) * SB_NL + 1);
                slot_f += SB_NL; if (slot_f >= SB_DEPTH) slot_f -= SB_DEPTH; }
        }
        const int clast = lw + (k - 1) * SB_NL;
#define SB_DRAIN(q) if (k > (q)) { wait_vm<10 * (q)>(); if (lane == 0) flg[slot_f] = (unsigned)(clast - (q) * SB_NL + 1); slot_f += SB_NL; if (slot_f >= SB_DEPTH) slot_f -= SB_DEPTH; }
        SB_DRAIN(4) SB_DRAIN(3) SB_DRAIN(2) SB_DRAIN(1) SB_DRAIN(0)
#undef SB_DRAIN
        static_assert(SB_Q == 6, "drain sequence is written for SB_Q = 6");
    }
    }
}

__device__ __forceinline__ float xsum_rows(float v, int lane) {
    v += __builtin_bit_cast(float, __builtin_amdgcn_ds_bpermute((lane ^ 16) << 2, __builtin_bit_cast(int, v)));
    v += __builtin_bit_cast(float, __builtin_amdgcn_ds_bpermute((lane ^ 32) << 2, __builtin_bit_cast(int, v)));
    return v;
}
__device__ __forceinline__ void p_chunkC(const Params& P, const bf16* proj, const ChunkBufs& CB, bf16* ymix, unsigned char* lds_, const int wv) {
    const int tid_ = wv * 64 + lane_fresh();
    const int h = wv, lane = tid_ & 63, fr = lane & 15, fq = lane >> 4;
    LAS unsigned char* GL0 = (LAS unsigned char*)lds_ + h * 16384 + lane * 16;
#pragma unroll
    for (int ks = 0; ks < 4; ++ks)
#pragma unroll
        for (int it = 0; it < 4; ++it) *(LAS bf16x8*)(GL0 + (ks * 4 + it) * 1024) = *(const bf16x8*)(CB.GLT + (size_t)(h * 64 + it * 16 + fr) * 128 + 32 * ks + 8 * fq);
    if (lane < 48) { const int a_ = lane >> 4, idx = lane & 15, c_ = h * 64 + (idx >> 2) * 16 + 4 * (idx & 3);
        const float* srcp = (a_ == 0) ? P.lnx_g : ((a_ == 1) ? P.lnx_b : P.rwkv_mu + 1024);
        *(LAS f32x4*)((LAS unsigned char*)lds_ + 131072 + h * 1024 + lane * 16) = *(const f32x4*)(srcp + c_); }
    for (int k_ = 0; ; ++k_) {
        const int grp = blockIdx.x + gridDim.x * (k_ >> 2), tile = grp * 4 + (k_ & 3);
        if (grp >= NTOK / 64) break;
        const int lane_ = lane_fresh();
        const int lane = lane_, fr = lane & 15, fq = lane >> 4;
        const LAS unsigned char* GL = (const LAS unsigned char*)lds_ + h * 16384 + lane * 16;
        const int tq = tile & 3, ch = (tile >> 2) & 127, b = tile >> 9;
        const size_t unit = (size_t)(b * 8 + h) * 128 + ch;
        const size_t rowbase = (size_t)b * SEQ + ch * 64;
        const int t = tq * 16 + fr; const size_t row = rowbase + t;
        const bool first = (ch == 0 && t == 0);
        const size_t prow = first ? row : row - 1;
        const unsigned char* uYI = CB.YI + unit * 8192; const unsigned char* uMQ = CB.MQ + unit * 16384; const unsigned char* uH0 = CB.H0 + unit * 8192;
        f32x4 acc[4], gacc[4]; u32x4 qf[2], hf[4], sg[4];
#pragma unroll
        for (int it = 0; it < 4; ++it) { const u32x2 yr = *(const u32x2*)(uYI + (tq * 4 + it) * 512 + lane * 8); acc[it][0] = bflo(yr.x); acc[it][1] = bfhi(yr.x); acc[it][2] = bflo(yr.y); acc[it][3] = bfhi(yr.y); gacc[it] = (f32x4){0.f, 0.f, 0.f, 0.f}; }
#pragma unroll
        for (int ks = 0; ks < 2; ++ks) qf[ks] = *(const u32x4*)(uMQ + 8192 + t * 128 + (32 * ks + 8 * fq) * 2);
#pragma unroll
        for (int it = 0; it < 4; ++it) hf[it] = *(const u32x4*)(uH0 + it * 1024 + lane * 16);
#pragma unroll
        for (int ks = 0; ks < 4; ++ks) sg[ks] = *(const u32x4*)(CB.PRE + row * 256 + 128 + 32 * ks + 8 * fq);
        asm volatile("" ::: "memory");
#pragma unroll
        for (int it = 0; it < 4; ++it) acc[it] = __builtin_amdgcn_mfma_f32_16x16x32_bf16(__builtin_bit_cast(bf16x8, hf[it]), __builtin_bit_cast(bf16x8, qf[0]), acc[it], 0, 0, 0);
        asm volatile("" ::: "memory");
#pragma unroll
        for (int it = 0; it < 4; ++it) hf[it] = *(const u32x4*)(uH0 + (4 + it) * 1024 + lane * 16);
#pragma unroll
        for (int it = 0; it < 4; ++it) acc[it] = __builtin_amdgcn_mfma_f32_16x16x32_bf16(__builtin_bit_cast(bf16x8, hf[it]), __builtin_bit_cast(bf16x8, qf[1]), acc[it], 0, 0, 0);
#pragma unroll
        for (int ks = 0; ks < 4; ++ks) {
            asm volatile("" ::: "memory");
#pragma unroll
            for (int it = 0; it < 4; ++it) gacc[it] = __builtin_amdgcn_mfma_f32_16x16x32_bf16(*(const LAS bf16x8*)(GL + (ks * 4 + it) * 1024), __builtin_bit_cast(bf16x8, sg[ks]), gacc[it], 0, 0, 0);
        }
        float s = 0.f;
#pragma unroll
        for (int it = 0; it < 4; ++it) s += (acc[it][0] + acc[it][1]) + (acc[it][2] + acc[it][3]);
        s = xsum_rows(s, lane);
        const float mean = s * (1.f / 64.f);
        float q = 0.f;
#pragma unroll
        for (int it = 0; it < 4; ++it)
#pragma unroll
            for (int r = 0; r < 4; ++r) { const float d = acc[it][r] - mean; q += d * d; }
        q = xsum_rows(q, lane);
        const float rstd = 1.0f / sqrtf(q * (1.f / 64.f) + GN_EPS);
        asm volatile("" ::: "memory");
        u32x2 cv[4], pv[4];
#pragma unroll
        for (int it = 0; it < 4; ++it) { const int c = h * 64 + it * 16 + 4 * fq;
            cv[it] = *(const u32x2*)(proj + row * INC + 1024 + c); pv[it] = *(const u32x2*)(proj + prow * INC + 1024 + c); }
        const float bonus = CB.BON[row * 8 + h];
#pragma unroll
        for (int it = 0; it < 4; ++it) {
            const int c = h * 64 + it * 16 + 4 * fq;
            const float cvf[4] = {bflo(cv[it].x), bfhi(cv[it].x), bflo(cv[it].y), bfhi(cv[it].y)};
            const float pvf[4] = {first ? 0.f : bflo(pv[it].x), first ? 0.f : bfhi(pv[it].x), first ? 0.f : bflo(pv[it].y), first ? 0.f : bfhi(pv[it].y)};
            const LAS unsigned char* PL = (const LAS unsigned char*)lds_ + 131072 + h * 1024 + (it * 4 + fq) * 16;
            const f32x4 lg = *(const LAS f32x4*)(PL), lb = *(const LAS f32x4*)(PL + 256), muv = *(const LAS f32x4*)(PL + 512);
            float o[4];
#pragma unroll
            for (int r = 0; r < 4; ++r) { const float v = cvf[r] + (pvf[r] - cvf[r]) * muv[r]; const float yn = (acc[it][r] - mean) * rstd * lg[r] + lb[r]; o[r] = (yn + bonus * v) * gacc[it][r]; }
            u32x2 w; w.x = pk2(o[0], o[1]); w.y = pk2(o[2], o[3]);
            *(u32x2*)(ymix + row * DM + c) = w;
        }
    }
}

struct AttnRaw { u32x4 k[3], v[3], q[2][2]; };
__device__ __forceinline__ void attn_issue(AttnRaw& R, const bf16* proj, int item, int tid, int wave, int lane) {
    const int kvh = item & 1, tile = (item >> 1) & 127, b = item >> 8, t0 = tile * 64, dc = tid & 7, fr = lane & 15, fq = lane >> 4;
    const size_t brow = (size_t)b * SEQ;
#pragma unroll
    for (int pass = 0; pass < 3; ++pass) {
        const int key = t0 - 128 + pass * 64 + (tid >> 3);
        const bf16* kp = proj + (brow + (key < 0 ? 0 : key)) * INC + 2304 + kvh * 64 + dc * 8;
        R.k[pass] = *(const u32x4*)kp; R.v[pass] = *(const u32x4*)(kp + 128);
    }
    const int head = kvh * 4 + (wave & 3);
#pragma unroll
    for (int qt = 0; qt < 2; ++qt)
#pragma unroll
        for (int ks = 0; ks < 2; ++ks) R.q[qt][ks] = *(const u32x4*)(proj + (brow + t0 + (wave >> 2) * 32 + qt * 16 + fr) * INC + RCOLS + head * 64 + 32 * ks + 8 * fq);
}
template <bool PRE_ISSUED>
__device__ __forceinline__ void p_attn3(const Params& P, const bf16* proj, bf16* ymix, unsigned char* lds_, int first_blk, int nblk, int item_lo, int item_hi, const int wv, const AttnRaw& pre) {
    if ((int)blockIdx.x < first_blk || (int)blockIdx.x >= first_blk + nblk) return;
    LAS unsigned char* L = (LAS unsigned char*)lds_;
    constexpr int KLD = 72, VLD = 200, O_KN = 0, O_VT = 192 * KLD * 2, O_BT = O_VT + 64 * VLD * 2, O_GK = O_BT + 4096, O_GQ = O_GK + 256;
    const int NITEM = item_hi;
    const int tid_ = wv * 64 + lane_fresh();
    const int tid = tid_, wave = wv, lane = tid & 63, fr = lane & 15, fq = lane >> 4, hq = wave & 3, qh = wave >> 2;
    LAS float* btab = (LAS float*)(L + O_BT);
    AttnRaw cur, nxt;
    const int item0 = item_lo + (int)blockIdx.x - first_blk;
    if constexpr (PRE_ISSUED) cur = pre;
    else if (item0 < NITEM) attn_issue(cur, proj, item0, tid, wave, lane);
    { const int dist = tid_ & 127, hw = (tid_ >> 7) & 3, bk = (int)T5B[dist] * 8 + hw;
      const float r0 = P.rel_bias[bk], r1 = P.rel_bias[bk + 4];
      btab[tid_] = 1.4426950408889634f * r0; btab[tid_ + 512] = 1.4426950408889634f * r1; }
    if (tid_ < 64) { *(LAS float*)(L + O_GK + tid_ * 4) = P.k_norm_g[tid_]; *(LAS float*)(L + O_GQ + tid_ * 4) = P.q_norm_g[tid_]; }
    float gqm = fabsf(P.q_norm_g[lane]), gkm = fabsf(P.k_norm_g[lane]);
    float bm0 = (lane < 32) ? fabsf(P.rel_bias[lane * 8 + hq]) : 0.f, bm1 = (lane < 32) ? fabsf(P.rel_bias[lane * 8 + 4 + hq]) : 0.f;
#pragma unroll
    for (int o = 1; o < 64; o <<= 1) { gqm = fmaxf(gqm, __shfl_xor(gqm, o)); gkm = fmaxf(gkm, __shfl_xor(gkm, o)); bm0 = fmaxf(bm0, __shfl_xor(bm0, o)); bm1 = fmaxf(bm1, __shfl_xor(bm1, o)); }
    const float mref0 = 8.0f * gqm * gkm + bm0, mref1 = 8.0f * gqm * gkm + bm1;
    const float sink0 = P.sinks[hq], sink1 = P.sinks[4 + hq];
    for (int item = item0; item < NITEM; item += nblk) {
        const int kvh = item & 1, tile = (item >> 1) & 127, b = item >> 8, t0 = tile * 64, head = kvh * 4 + hq;
        const size_t brow = (size_t)b * SEQ;
        __syncthreads();
        { const int dc = tid & 7;
          const f32x4 g0 = *(const LAS f32x4*)(L + O_GK + dc * 32), g1 = *(const LAS f32x4*)(L + O_GK + dc * 32 + 16);
#pragma unroll
          for (int pass = 0; pass < 3; ++pass) {
              const int kl = pass * 64 + (tid >> 3), key = t0 - 128 + kl;
              const u32x4 zero4 = (u32x4){0u, 0u, 0u, 0u};
              const u32x4 raw = (key >= 0) ? cur.k[pass] : zero4, vraw = (key >= 0) ? cur.v[pass] : zero4;
              float f[8]; float ss = 0.f;
#pragma unroll
              for (int e = 0; e < 4; ++e) { f[2 * e] = bflo(raw[e]); f[2 * e + 1] = bfhi(raw[e]); ss += f[2 * e] * f[2 * e] + f[2 * e + 1] * f[2 * e + 1]; }
              ss = sum8(ss);
              const float rs = 1.0f / sqrtf(ss * (1.f / 64.f) + NORM_EPS);
              u32x4 o; o.x = pk2(f[0] * rs * g0[0], f[1] * rs * g0[1]); o.y = pk2(f[2] * rs * g0[2], f[3] * rs * g0[3]); o.z = pk2(f[4] * rs * g1[0], f[5] * rs * g1[1]); o.w = pk2(f[6] * rs * g1[2], f[7] * rs * g1[3]);
              *(LAS u32x4*)(L + O_KN + (kl * KLD + dc * 8) * 2) = o;
#pragma unroll
              for (int e = 0; e < 4; ++e) { *(LAS unsigned short*)(L + O_VT + ((dc * 8 + 2 * e) * VLD + kl) * 2) = (unsigned short)(vraw[e] & 0xffffu); *(LAS unsigned short*)(L + O_VT + ((dc * 8 + 2 * e + 1) * VLD + kl) * 2) = (unsigned short)(vraw[e] >> 16); }
          } }
        const float MREF = kvh ? mref1 : mref0;
        const float sinkterm = fexp((kvh ? sink1 : sink0) - MREF);
        const u32x4 q00 = cur.q[0][0], q01 = cur.q[0][1], q10 = cur.q[1][0], q11 = cur.q[1][1];
        if (item + nblk < NITEM) attn_issue(nxt, proj, item + nblk, tid, wave, lane);
        __syncthreads();
#pragma unroll 1
        for (int qt = 0; qt < 2; ++qt) {
            const int tq0 = qh * 32 + qt * 16, tq = tq0 + fr, kt0 = tq0 >> 4;
            const size_t row = brow + t0 + tq;
            bf16x8 qfrag[2];
            { u32x4 qraw[2]; qraw[0] = qt ? q10 : q00; qraw[1] = qt ? q11 : q01; float ss = 0.f;
#pragma unroll
              for (int ks = 0; ks < 2; ++ks) {
#pragma unroll
                  for (int e = 0; e < 4; ++e) { const float lo = bflo(qraw[ks][e]), hi = bfhi(qraw[ks][e]); ss += lo * lo + hi * hi; } }
              ss += __shfl_xor(ss, 16); ss += __shfl_xor(ss, 32);
              const float rs = (0.125f * 1.4426950408889634f) / sqrtf(ss * (1.f / 64.f) + NORM_EPS);
#pragma unroll
              for (int ks = 0; ks < 2; ++ks) { const f32x4 g0 = *(const LAS f32x4*)(L + O_GQ + (32 * ks + 8 * fq) * 4), g1 = *(const LAS f32x4*)(L + O_GQ + (32 * ks + 8 * fq + 4) * 4);
                  u32x4 o; o.x = pk2(bflo(qraw[ks][0]) * rs * g0[0], bfhi(qraw[ks][0]) * rs * g0[1]); o.y = pk2(bflo(qraw[ks][1]) * rs * g0[2], bfhi(qraw[ks][1]) * rs * g0[3]);
                  o.z = pk2(bflo(qraw[ks][2]) * rs * g1[0], bfhi(qraw[ks][2]) * rs * g1[1]); o.w = pk2(bflo(qraw[ks][3]) * rs * g1[2], bfhi(qraw[ks][3]) * rs * g1[3]);
                  qfrag[ks] = __builtin_bit_cast(bf16x8, o); } }
            u32x2 ppk[9]; float lsum = 0.f;
            const float nm = -1.4426950408889634f * MREF;
            const f32x4 sinit = (f32x4){nm, nm, nm, nm};
            const LAS float* bt = btab + kvh * 512 + hq * 128 + (128 + fr - 4 * fq);
            const bool lowt = (t0 < 128);
#pragma unroll
            for (int m = 0; m < 9; ++m) {
                const int kt = kt0 + m;
                f32x4 s = sinit;
#pragma unroll
                for (int ks = 0; ks < 2; ++ks) { const bf16x8 kf = *(const LAS bf16x8*)(L + O_KN + ((16 * kt + fr) * KLD + 32 * ks + 8 * fq) * 2); s = __builtin_amdgcn_mfma_f32_16x16x32_bf16(kf, qfrag[ks], s, 0, 0, 0); }
                float p[4];
#pragma unroll
                for (int r = 0; r < 4; ++r) {
                    const int doff = 16 * m + r;
                    float pv = __builtin_amdgcn_exp2f(s[r] + bt[-doff]);
                    if (m == 0) pv = (fr < 4 * fq + r) ? pv : 0.f;
                    if (m == 8) pv = (fr >= 4 * fq + r) ? pv : 0.f;
                    if (lowt) pv = (t0 - 128 + 16 * kt + 4 * fq + r >= 0) ? pv : 0.f;
                    p[r] = pv; lsum += pv; }
                ppk[m].x = pk2(p[0], p[1]); ppk[m].y = pk2(p[2], p[3]);
            }
            f32x4 o[4];
#pragma unroll
            for (int dt = 0; dt < 4; ++dt) o[dt] = (f32x4){0.f, 0.f, 0.f, 0.f};
#pragma unroll
            for (int mm = 0; mm < 5; ++mm) {
                u32x4 pf; pf.x = ppk[2 * mm].x; pf.y = ppk[2 * mm].y;
                if (mm < 4) { pf.z = ppk[2 * mm + 1].x; pf.w = ppk[2 * mm + 1].y; } else { pf.z = 0u; pf.w = 0u; }
#pragma unroll
                for (int dt = 0; dt < 4; ++dt) {
                    const LAS unsigned char* vp = L + O_VT + ((16 * dt + fr) * VLD + 16 * (kt0 + 2 * mm) + 4 * fq) * 2;
                    const u32x2 v0 = *(const LAS u32x2*)vp; u32x2 v1; v1.x = 0u; v1.y = 0u;
                    if (mm < 4) v1 = *(const LAS u32x2*)(vp + 32);
                    u32x4 vf; vf.x = v0.x; vf.y = v0.y; vf.z = v1.x; vf.w = v1.y;
                    o[dt] = __builtin_amdgcn_mfma_f32_16x16x32_bf16(__builtin_bit_cast(bf16x8, vf), __builtin_bit_cast(bf16x8, pf), o[dt], 0, 0, 0);
                }
            }
            lsum += __shfl_xor(lsum, 16); lsum += __shfl_xor(lsum, 32);
            const float inv = 1.0f / (lsum + sinkterm);
#pragma unroll
            for (int dt = 0; dt < 4; ++dt) { u32x2 w; w.x = pk2(o[dt][0] * inv, o[dt][1] * inv); w.y = pk2(o[dt][2] * inv, o[dt][3] * inv);
                *(u32x2*)(ymix + row * DM + 512 + head * 64 + 16 * dt + 4 * fq) = w; }
        }
        cur = nxt;
    }
}

constexpr int LDS_BYTES = 163840;
#define GRID_SYNC() xcd_barrier(bar)
__global__ void __launch_bounds__(512, 2) fwd_megakernel(Params P) {
    extern __shared__ __attribute__((aligned(16))) unsigned char lds[];
    cg::grid_group grid = cg::this_grid();
    const int wv = __builtin_amdgcn_readfirstlane((int)(threadIdx.x >> 6));
    float* ldsf = (float*)lds;
    volatile LAS unsigned* MISC = (volatile LAS unsigned*)((LAS unsigned char*)lds + LDS_BYTES - 256);
    if (threadIdx.x < 32) MISC[threadIdx.x] = 0u;
    __syncthreads();
    XcdBarrier bar = xcd_barrier_post((unsigned*)(P.ws + WS_CTL) + 4096, MISC + 8, wv);
    unsigned char* ws = P.ws; float* out = P.out;
    float* mod = (float*)(ws + WS_MOD); float* SSQ = (float*)(ws + WS_SSQ); float* CGU = (float*)(ws + WS_CGU); float* C1 = (float*)(ws + WS_C1); float* RSTD1 = (float*)(ws + WS_RSTD1);
    bf16* Win_t = (bf16*)(ws + WS_WIN); bf16* Wout_t = (bf16*)(ws + WS_WOUT); bf16* Wgu_t = (bf16*)(ws + WS_WGU); bf16* Wdn_t = (bf16*)(ws + WS_WDN);
    bf16* H1 = (bf16*)(ws + WS_XB); bf16* PROJ = (bf16*)(ws + WS_PROJ); bf16* YMIX = (bf16*)(ws + WS_YMIX); bf16* H2 = (bf16*)(ws + WS_H2); bf16* ACT = (bf16*)(ws + WS_PROJ);
    ChunkBufs CB; CB.DG = (unsigned char*)out; CB.YI = (unsigned char*)out + (size_t)32 * MiB; CB.MQ = (unsigned char*)out + (size_t)64 * MiB; CB.H0 = ws + WS_H2; CB.BON = (float*)(ws + WS_BON); CB.PRE = (const bf16*)(ws + WS_PRE);
    CB.WLT = (const bf16*)(ws + WS_LORA); CB.ALT = CB.WLT + 512 * 64; CB.GLT = CB.ALT + 512 * 64;

    float* par = (float*)(ws + WS_PAR);
    { const int gt = blockIdx.x * 512 + wv * 64 + lane_fresh();
      if (gt < 1792) par[PO_MU + gt] = P.rwkv_mu[gt];
      if (gt < 512) { par[PO_W0 + gt] = P.w0[gt]; par[PO_A0 + gt] = P.a0[gt]; par[PO_KK + gt] = P.k_k[gt]; par[PO_KA + gt] = P.k_a[gt]; par[PO_RK + gt] = P.r_k[gt]; par[PO_LG + gt] = P.lnx_g[gt]; par[PO_LB + gt] = P.lnx_b[gt]; }
      if (gt < 64) { par[PO_QG + gt] = P.q_norm_g[gt]; par[PO_KG + gt] = P.k_norm_g[gt]; }
      if (gt < 8) par[PO_SINK + gt] = P.sinks[gt];
      if (gt < 256) par[PO_RB + gt] = P.rel_bias[gt];
      if (gt < 1024) { par[PO_N1 + gt] = P.norm1_g[gt]; par[PO_N2 + gt] = P.norm2_g[gt]; } }
    p_mod(P, mod, ldsf, wv);
    p_xb(P.x, H1, RSTD1, wv);
    p_transposes(P, Win_t, Wout_t, Wgu_t, Wdn_t, (bf16*)CB.WLT, (bf16*)CB.ALT, (bf16*)CB.GLT, ldsf, wv);
    if (gridDim.y == 0x7fff) grid.sync();
    GRID_SYNC();
    p_fold(P.w_in, P.w_gate, P.w_up, par + PO_N1, par + PO_N2, mod, Win_t, C1, Wgu_t, CGU, ldsf, wv);
    GRID_SYNC();
    { pg8::Gemm g; g.A = H1; g.Bt = Win_t; g.M = NTOK; g.N = INC; g.K = DM; g.pad = 0; g.bstride = (size_t)INC * DM * 2; pg8::StaticOrder S; S.init(NTOK, INC, gridDim.x, blockIdx.x, 2);
      EpiStoreBf16Norm E; E.O = PROJ; E.rstd = RSTD1; E.cvec = C1; E.ldc = INC; E.pad = 0;
      pg8::gemm_phase<EpiStoreBf16Norm, pg8::StaticOrder, true, true>((PG8_LAS unsigned char*)lds, g, S, E, wv); }
    GRID_SYNC();
    const Params Q = { P.x, nullptr, nullptr, nullptr, nullptr, nullptr, par + PO_MU, par + PO_W0, nullptr, par + PO_A0, nullptr, nullptr, par + PO_KK, par + PO_KA, par + PO_RK, par + PO_LG, par + PO_LB,
                       par + PO_QG, par + PO_KG, par + PO_SINK, par + PO_RB, nullptr, nullptr, nullptr, nullptr, nullptr, nullptr, nullptr };
    AttnRaw a0;
    { const int ln = lane_fresh(); if ((int)blockIdx.x < 512) attn_issue(a0, PROJ, blockIdx.x, wv * 64 + ln, wv, ln); }
    p_pre(Q, PROJ, (bf16*)(ws + WS_PRE), wv);
    p_attn3<true>(Q, PROJ, YMIX, lds, 0, gridDim.x, 0, 512, wv, a0);
    if (gridDim.x == 256) { asm volatile("s_waitcnt vmcnt(0)" ::: "memory"); __syncthreads(); }
    else GRID_SYNC();
    p_chunkA(Q, PROJ, CB, lds, wv);
    GRID_SYNC();
    p_chunkB(CB, lds, wv);
    { const int fb = (gridDim.x >= 256) ? 128 : 0;
      p_attn3<false>(Q, PROJ, YMIX, lds, fb, gridDim.x - fb, 512, 1024, wv, a0); }
    GRID_SYNC();
    p_chunkC(Q, PROJ, CB, YMIX, lds, wv);
    GRID_SYNC();
    { pg8::Gemm g; g.A = YMIX; g.Bt = Wout_t; g.M = NTOK; g.N = DM; g.K = DM; g.pad = 0; g.bstride = 0; pg8::StaticOrder S; S.init(NTOK, DM, gridDim.x, blockIdx.x);
      EpiResidNormB E; E.base = H1; E.gate = mod + 2 * DM; E.hb = H2; E.ssq = SSQ;
      pg8::gemm_phase<EpiResidNormB, pg8::StaticOrder, true, true>((PG8_LAS unsigned char*)lds, g, S, E, wv); }
    GRID_SYNC();
    { pg8::Gemm g; g.A = H2; g.Bt = Wgu_t; g.M = NTOK; g.N = 2 * DFF; g.K = DM; g.pad = 0; g.bstride = (size_t)2 * DFF * DM * 2; pg8::StaticOrder S; S.init(NTOK, 2 * DFF, gridDim.x, blockIdx.x);
      EpiSwigluNorm E; E.act = ACT; E.ssq = SSQ; E.cgu = CGU;
      pg8::gemm_phase<EpiSwigluNorm, pg8::StaticOrder, true, true>((PG8_LAS unsigned char*)lds, g, S, E, wv); }
    GRID_SYNC();
    { pg8::Gemm g; g.A = ACT; g.Bt = Wdn_t; g.M = NTOK; g.N = DM; g.K = DFF; g.pad = 0; g.bstride = 0; pg8::StaticOrder S; S.init(NTOK, DM, gridDim.x, blockIdx.x);
      EpiFinalB E; E.hb = H2; E.out = out; E.gate = mod + 5 * DM;
      pg8::gemm_phase<EpiFinalB, pg8::StaticOrder, true, true>((PG8_LAS unsigned char*)lds, g, S, E, wv); }
}

extern "C" void kernel_launch(void* const* d_in, const int* in_sizes, int n_in, void* d_out, int out_size, void* d_ws, size_t ws_size, hipStream_t stream) {
    static int grid_blocks = 0;
    if (grid_blocks == 0) {
        if (n_in != 26 || in_sizes[0] != NTOK * DM || out_size != NTOK * DM || ws_size < WS_END) { fprintf(stderr, "kernel_launch: unexpected shapes (n_in %d, ws %zu)\n", n_in, ws_size); grid_blocks = -1; return; }
        int dev = 0, cus = 0, per_cu = 0;
        (void)hipGetDevice(&dev);
        (void)hipDeviceGetAttribute(&cus, hipDeviceAttributeMultiprocessorCount, dev);
        if (hipFuncSetAttribute((const void*)fwd_megakernel, hipFuncAttributeMaxDynamicSharedMemorySize, LDS_BYTES) != hipSuccess) { fprintf(stderr, "kernel_launch: hipFuncSetAttribute failed\n"); grid_blocks = -1; return; }
        if (hipOccupancyMaxActiveBlocksPerMultiprocessor(&per_cu, (const void*)fwd_megakernel, 512, LDS_BYTES) != hipSuccess || per_cu < 1) { fprintf(stderr, "kernel_launch: occupancy query failed (%d)\n", per_cu); grid_blocks = -1; return; }
        grid_blocks = cus * 1;
    }
    if (grid_blocks < 0) return;
    (void)hipMemsetAsync((unsigned char*)d_ws + WS_CTL, 0, CTL_ZERO_BYTES, stream);
    Params p; memset(&p, 0, sizeof(p));
    const float** pp = (const float**)&p;
    for (int i = 0; i < 26; ++i) pp[i] = (const float*)d_in[i];
    p.out = (float*)d_out; p.ws = (unsigned char*)d_ws;
    void* args[] = {&p};
    hipError_t e = hipLaunchCooperativeKernel((const void*)fwd_megakernel, dim3(grid_blocks), dim3(512), args, LDS_BYTES, stream);
    if (e != hipSuccess) fprintf(stderr, "cooperative launch failed: %s (grid %d)\n", hipGetErrorString(e), grid_blocks);
}
```
